# Optimizing an MI355X kernel written in HIP

```python
import jax, jax.numpy as jnp
from jax import lax
import numpy as np

D_MODEL = 1024
BATCH = 2
SEQ = 8192
DEPTH = 4

N_MIXERS = 3
N_A = (DEPTH + 2) // 3
N_B = (DEPTH + 1) // 3
N_C = DEPTH // 3
D_RNN = 1280
A_HEADS = 16
A_HEAD_DIM = D_RNN // A_HEADS
A_CONV = 4
LRU_C = 8.0
D_SGU = D_MODEL
SGU_CHUNK = 128
SGU_GROUPS = 8
SGU_GROUP_DIM = D_SGU // SGU_GROUPS
D_CONV = D_MODEL
C_CONV = 3
D_FF = 4 * D_MODEL
EPS = 1e-6

kernel_name = "hybrid_rglru_sgu_shortconv_trunk"


def _rmsnorm(x, g):
    x32 = x.astype(jnp.float32)
    y = x32 * lax.rsqrt(jnp.mean(x32 * x32, axis=-1, keepdims=True) + EPS)
    return y.astype(x.dtype) * g


def _causal_dwconv(x, w):
    k = w.shape[0]
    return lax.conv_general_dilated(
        x, w[:, None, :].astype(x.dtype), window_strides=(1,),
        padding=[(k - 1, 0)], dimension_numbers=("NWC", "WIO", "NWC"),
        feature_group_count=x.shape[-1])


def _lru_combine(left, right):
    a_l, b_l = left
    a_r, b_r = right
    return a_l * a_r, a_r * b_l + b_r


def _rglru_mixer(h, w_in, conv_w, conv_b, gate_a_w, gate_a_b, gate_x_w, gate_x_b, lam, w_out):
    b, s, _ = h.shape
    gate, xr = jnp.split(h @ w_in, 2, axis=-1)
    gate = jax.nn.gelu(gate)
    xr = _causal_dwconv(xr, conv_w) + conv_b
    xh = xr.reshape(b, s, A_HEADS, A_HEAD_DIM)
    r = jax.nn.sigmoid(jnp.einsum("bshi,hij->bshj", xh, gate_a_w).reshape(b, s, D_RNN) + gate_a_b)
    ig = jax.nn.sigmoid(jnp.einsum("bshi,hij->bshj", xh, gate_x_w).reshape(b, s, D_RNN) + gate_x_b)
    log_a = -LRU_C * r.astype(jnp.float32) * jax.nn.softplus(-lam.astype(jnp.float32))
    a = jnp.exp(log_a)
    u = jnp.sqrt(-jnp.expm1(2.0 * log_a)) * (ig * xr).astype(jnp.float32)
    _, hs = lax.associative_scan(_lru_combine, (a, u), axis=1)
    return (hs.astype(h.dtype) * gate) @ w_out


def _sgu_mixer(h, w_in, norm_g, w_s, s_bias, w_out):
    b, s, _ = h.shape
    z = jax.nn.gelu(h @ w_in)
    u, v = jnp.split(z, 2, axis=-1)
    v = _rmsnorm(v, norm_g)
    n_chunks = s // SGU_CHUNK
    v = v.reshape(b, n_chunks, SGU_CHUNK, SGU_GROUPS, SGU_GROUP_DIM)
    causal = jnp.tril(jnp.ones((SGU_CHUNK, SGU_CHUNK), dtype=bool))
    w_causal = jnp.where(causal[None], w_s, jnp.zeros((), w_s.dtype))
    mixed = jnp.einsum("gts,bnsgc->bntgc", w_causal, v) + s_bias.T[None, None, :, :, None]
    y = u * mixed.reshape(b, s, D_SGU)
    return y @ w_out


def _shortconv_mixer(h, w_in, conv_w, w_out):
    gb, gc, xv = jnp.split(h @ w_in, 3, axis=-1)
    y = gb * _causal_dwconv(gc * xv, conv_w)
    return y @ w_out


def _sqrelu_mlp(h, w1, w2):
    return jnp.square(jax.nn.relu(h @ w1)) @ w2


def setup_inputs(seed: int = 0) -> dict:
    key = jax.random.key(seed)
    ks = jax.random.split(key, 24)
    f32 = jnp.float32

    def w(k, shape, fan_in):
        return jax.random.normal(k, shape, f32) * (fan_in ** -0.5)

    def gain(k, shape):
        return 1.0 + 0.1 * jax.random.normal(k, shape, f32)

    def bias(k, shape, scale=0.1):
        return scale * jax.random.normal(k, shape, f32)

    a_c = jax.random.uniform(ks[11], (N_A, D_RNN), f32, minval=0.9, maxval=0.999)
    a0 = a_c ** (1.0 / LRU_C)
    a_lambda = jnp.log(a0) - jnp.log1p(-a0)

    return {
        "x": jax.random.normal(ks[0], (BATCH, SEQ, D_MODEL), f32),
        "norm_mix_g": gain(ks[1], (DEPTH, D_MODEL)),
        "norm_mlp_g": gain(ks[2], (DEPTH, D_MODEL)),
        "final_norm_g": gain(ks[3], (D_MODEL,)),
        "a_w_in": w(ks[4], (N_A, D_MODEL, 2 * D_RNN), D_MODEL),
        "a_conv_w": w(ks[5], (N_A, A_CONV, D_RNN), A_CONV),
        "a_conv_b": bias(ks[6], (N_A, D_RNN)),
        "a_gate_a_w": w(ks[7], (N_A, A_HEADS, A_HEAD_DIM, A_HEAD_DIM), A_HEAD_DIM),
        "a_gate_a_b": bias(ks[8], (N_A, D_RNN)),
        "a_gate_x_w": w(ks[9], (N_A, A_HEADS, A_HEAD_DIM, A_HEAD_DIM), A_HEAD_DIM),
        "a_gate_x_b": bias(ks[10], (N_A, D_RNN)),
        "a_lambda": a_lambda,
        "a_w_out": w(ks[12], (N_A, D_RNN, D_MODEL), D_RNN),
        "b_w_in": w(ks[13], (N_B, D_MODEL, 2 * D_SGU), D_MODEL),
        "b_norm_g": gain(ks[14], (N_B, D_SGU)),
        "b_w_s": w(ks[15], (N_B, SGU_GROUPS, SGU_CHUNK, SGU_CHUNK), SGU_CHUNK),
        "b_s_bias": gain(ks[16], (N_B, SGU_GROUPS, SGU_CHUNK)),
        "b_w_out": w(ks[17], (N_B, D_SGU, D_MODEL), D_SGU),
        "c_w_in": w(ks[18], (N_C, D_MODEL, 3 * D_CONV), D_MODEL),
        "c_conv_w": w(ks[19], (N_C, C_CONV, D_CONV), C_CONV),
        "c_w_out": w(ks[20], (N_C, D_CONV, D_MODEL), D_CONV),
        "mlp_w1": w(ks[21], (DEPTH, D_MODEL, D_FF), D_MODEL),
        "mlp_w2": w(ks[22], (DEPTH, D_FF, D_MODEL), D_FF),
    }


def reference(x, norm_mix_g, norm_mlp_g, final_norm_g,
              a_w_in, a_conv_w, a_conv_b, a_gate_a_w, a_gate_a_b, a_gate_x_w, a_gate_x_b, a_lambda, a_w_out,
              b_w_in, b_norm_g, b_w_s, b_s_bias, b_w_out,
              c_w_in, c_conv_w, c_w_out,
              mlp_w1, mlp_w2):
    for i in range(DEPTH):
        kind, j = i % N_MIXERS, i // N_MIXERS
        h = _rmsnorm(x, norm_mix_g[i])
        if kind == 0:
            mix = _rglru_mixer(h, a_w_in[j], a_conv_w[j], a_conv_b[j], a_gate_a_w[j], a_gate_a_b[j],
                               a_gate_x_w[j], a_gate_x_b[j], a_lambda[j], a_w_out[j])
        elif kind == 1:
            mix = _sgu_mixer(h, b_w_in[j], b_norm_g[j], b_w_s[j], b_s_bias[j], b_w_out[j])
        else:
            mix = _shortconv_mixer(h, c_w_in[j], c_conv_w[j], c_w_out[j])
        x = x + mix
        x = x + _sqrelu_mlp(_rmsnorm(x, norm_mlp_g[i]), mlp_w1[i], mlp_w2[i])
    return _rmsnorm(x, final_norm_g)
```

```cpp
#include <hip/hip_runtime.h>
#include <hip/hip_cooperative_groups.h>
#include <cstdio>
#include <cstdint>
namespace cg = cooperative_groups;

#ifndef PHMASK
#define PHMASK 0xFFFFFFFFu
#endif
#ifndef MK_MULTI
#define MK_MULTI 0
#endif

#define LAS __attribute__((address_space(3)))
typedef unsigned short bf16_t;
typedef short bf16x8 __attribute__((ext_vector_type(8)));
typedef float f32x4 __attribute__((ext_vector_type(4)));
typedef float f32x2 __attribute__((ext_vector_type(2)));
typedef unsigned u32x4 __attribute__((ext_vector_type(4)));
typedef unsigned u32x2 __attribute__((ext_vector_type(2)));

constexpr int SEQ = 8192, M = 2 * SEQ, D = 1024, DR = 1280, FF = 4096, NH = 16, HD = 80;
constexpr float EPS = 1e-6f, LOG2E = 1.4426950408889634f;
constexpr int NPHASE = 26;

constexpr size_t MiB = 1u << 20;
constexpr size_t WS_SSP = 0;
constexpr size_t WS_GW = 1 * MiB;
constexpr size_t WS_WSB = 2 * MiB;
constexpr size_t WS_W = 2 * MiB + 256 * 1024;
constexpr size_t W_AWIN = WS_W, W_AWOUT = WS_W + 10 * MiB, W_BWIN = WS_W + 15 * MiB, W_BWOUT = WS_W + 19 * MiB, W_CWIN = WS_W + 21 * MiB,
                 W_CWOUT = WS_W + 27 * MiB, W_W1 = WS_W + 29 * MiB, W_W2 = WS_W + 61 * MiB;
constexpr size_t WS_XB = WS_W + 93 * MiB;
constexpr size_t WS_BIG = WS_XB + 32 * MiB;
constexpr size_t WS_END = WS_BIG + 128 * MiB;
constexpr size_t A_G = 0, A_XR = 40 * MiB, A_Y = 80 * MiB, A_AGG = 120 * MiB, A_CARRY = 124 * MiB;
constexpr size_t B_U = 0, B_V = 32 * MiB, B_Y = 64 * MiB, B_SSV = 96 * MiB;
constexpr size_t C_GCX = 0, C_Y = 96 * MiB;

constexpr int LDS_BYTES = 147456;

namespace pg8 {
constexpr int BM = 256, BK = 64, HALF = 128, HTB = HALF * BK * 2, STAGE_BYTES = 8 * HTB, NXCD = 8, WGM = 8;
__host__ __device__ __forceinline__ int lds_byte(int r, int c) { const int st = (r >> 4) * 2 + (c >> 5), rr = r & 15, cc = c & 31, ob = rr * 64 + cc * 2; return st * 1024 + (ob ^ (((ob >> 9) & 1) << 5)); }
__host__ __device__ __forceinline__ void stage_rc(int b, int& R, int& C) { const int st = b / 1024, sb = b % 1024, swz = sb ^ (((sb >> 9) & 1) << 5); R = (st >> 1) * 16 + swz / 64; C = (st & 1) * 32 + (swz % 64) / 2; }
__host__ __device__ __forceinline__ int perm32(int rho) { const int n = rho >> 4, i = rho & 15; return 8 * (i >> 2) + 4 * n + (i & 3); }

struct Unit { int pm, pn; };
struct Gemm { const bf16_t* A; const bf16_t* Bt; int M, N, K; };

struct StaticOrder {
    int nM, nN, nwg, G, c;
    __host__ __device__ void init(int M_, int N_, int G_, int c_) { nM = M_ / BM; nN = N_ / BM; nwg = nM * nN; G = G_; c = c_; }
    __host__ __device__ bool next(int i, Unit& u) const {
        const long L = (long)i * G + c; if (L >= nwg) return false;
        int wgid = (int)L; { const int q = nwg / NXCD, r = nwg % NXCD, xcd = wgid % NXCD, off = wgid / NXCD; wgid = (xcd < r ? xcd * (q + 1) : r * (q + 1) + (xcd - r) * q) + off; }
        const int nig = WGM * nN, gid = wgid / nig, fm = gid * WGM, gsz = (nM - fm) < WGM ? (nM - fm) : WGM;
        u.pm = fm + ((wgid % nig) % gsz); u.pn = (wgid % nig) / gsz; return true;
    }
};

__device__ __forceinline__ unsigned cvt_pk_bf16(float lo, float hi) { unsigned r; asm volatile("v_cvt_pk_bf16_f32 %0, %1, %2" : "=v"(r) : "v"(lo), "v"(hi)); return r; }
__device__ __forceinline__ float fast_rcp(float x) { return __builtin_amdgcn_rcpf(x); }
__device__ __forceinline__ float fast_exp2(float x) { return __builtin_amdgcn_exp2f(x); }
__device__ __forceinline__ float sigmoidf_(float z) { return fast_rcp(1.0f + fast_exp2(-LOG2E * z)); }
__device__ __forceinline__ float gelu_tanh(float x) { const float z = x * (1.0f + 0.044715f * x * x); return x * fast_rcp(1.0f + fast_exp2(-2.0f * 0.7978845608028654f * LOG2E * z)); }

__device__ __forceinline__ float row_rs(const float* ssp, int row, int fq) {
    const f32x4 p = *(const f32x4*)(ssp + (size_t)row * 16 + 4 * fq);
    float s = (p[0] + p[1]) + (p[2] + p[3]);
    s += __shfl_xor(s, 16); s += __shfl_xor(s, 32);
    return __builtin_amdgcn_rsqf(s * (1.0f / 1024.0f) + EPS);
}

template <int MODE> struct EpiAct {
    static constexpr bool PERM = true, AFTER_DRAIN = false;
    bf16_t* O; int ldc; int split_cols; size_t split_stride; const float* ssp; float* ssv;
    __device__ __forceinline__ void operator()(const f32x4 (&acc)[2][2][4][2], const Unit& u, int wr, int wc, int fr, int fq) const {
        const int row0 = u.pm * BM + wr * 64 + fr; int colt = u.pn * BM; bf16_t* base = O; int t = 0;
        if (split_cols) { t = colt / split_cols; base += (size_t)t * split_stride; colt -= t * split_cols; }
        const int col0 = colt + wc * 32 + 8 * fq;
#pragma unroll
        for (int ai = 0; ai < 2; ++ai)
#pragma unroll
            for (int m = 0; m < 4; ++m) {
                const int row = row0 + ai * HALF + m * 16;
                const float rs = row_rs(ssp, row, fq);
                bf16_t* rowp = base + (size_t)row * ldc + col0; float vs = 0.f;
#pragma unroll
                for (int bj = 0; bj < 2; ++bj) {
                    f32x4 v0 = acc[ai][bj][m][0] * rs, v1 = acc[ai][bj][m][1] * rs;
                    if (MODE == 0) { if (t == 0) {
#pragma unroll
                        for (int j = 0; j < 4; ++j) { v0[j] = gelu_tanh(v0[j]); v1[j] = gelu_tanh(v1[j]); } } }
                    if (MODE == 1) {
#pragma unroll
                        for (int j = 0; j < 4; ++j) { const float a = fmaxf(v0[j], 0.f), b = fmaxf(v1[j], 0.f); v0[j] = a * a; v1[j] = b * b; } }
                    if (MODE == 2) {
#pragma unroll
                        for (int j = 0; j < 4; ++j) { v0[j] = gelu_tanh(v0[j]); v1[j] = gelu_tanh(v1[j]); }
                        vs += (v0[0] * v0[0] + v0[1] * v0[1]) + (v0[2] * v0[2] + v0[3] * v0[3]) + (v1[0] * v1[0] + v1[1] * v1[1]) + (v1[2] * v1[2] + v1[3] * v1[3]); }
                    u32x4 w; w.x = cvt_pk_bf16(v0[0], v0[1]); w.y = cvt_pk_bf16(v0[2], v0[3]); w.z = cvt_pk_bf16(v1[0], v1[1]); w.w = cvt_pk_bf16(v1[2], v1[3]);
                    *(u32x4*)(rowp + bj * HALF) = w;
                }
                if (MODE == 2) { vs += __shfl_xor(vs, 16); vs += __shfl_xor(vs, 32);
                    if (t == 1 && fq == 0) ssv[(size_t)row * 16 + (u.pn - 4) * 4 + wc] = vs; }
            }
    }
};
struct EpiRes {
    static constexpr bool PERM = true, AFTER_DRAIN = false;
    const float* base; float* out; bf16_t* xb; float* ssp;
    __device__ __forceinline__ void operator()(const f32x4 (&acc)[2][2][4][2], const Unit& u, int wr, int wc, int fr, int fq) const {
        const int row0 = u.pm * BM + wr * 64 + fr, col0 = u.pn * BM + wc * 32 + 8 * fq;
#pragma unroll
        for (int ai = 0; ai < 2; ++ai)
#pragma unroll
            for (int m = 0; m < 4; ++m) {
                const int row = row0 + ai * HALF + m * 16; float ss = 0.f;
#pragma unroll
                for (int bj = 0; bj < 2; ++bj) {
                    const size_t off = (size_t)row * D + col0 + bj * HALF;
                    const f32x4 b0 = *(const f32x4*)(base + off), b1 = *(const f32x4*)(base + off + 4);
                    const f32x4 v0 = acc[ai][bj][m][0] + b0, v1 = acc[ai][bj][m][1] + b1;
                    *(f32x4*)(out + off) = v0; *(f32x4*)(out + off + 4) = v1;
                    ss += (v0[0] * v0[0] + v0[1] * v0[1]) + (v0[2] * v0[2] + v0[3] * v0[3]) + (v1[0] * v1[0] + v1[1] * v1[1]) + (v1[2] * v1[2] + v1[3] * v1[3]);
                    u32x4 w; w.x = cvt_pk_bf16(v0[0], v0[1]); w.y = cvt_pk_bf16(v0[2], v0[3]); w.z = cvt_pk_bf16(v1[0], v1[1]); w.w = cvt_pk_bf16(v1[2], v1[3]);
                    *(u32x4*)(xb + off) = w;
                }
                ss += __shfl_xor(ss, 16); ss += __shfl_xor(ss, 32);
                if (fq == 0) ssp[(size_t)row * 16 + u.pn * 4 + wc] = ss;
            }
    }
};

template <class Epi, class Sched, bool ALIGN_EPI = true>
__device__ __forceinline__ void gemm_phase(LAS unsigned char* lds, const Gemm g, const Sched& S, const Epi& E) {
    int tid_o = threadIdx.x; asm volatile("" : "+v"(tid_o));
    const int tid = tid_o, wid = __builtin_amdgcn_readfirstlane(tid >> 6), lane = tid & 63, wr = wid >> 2, wc = wid & 3, fr = lane & 15, fq = lane >> 4;
    const int K = g.K, nt = K / BK;
    unsigned voffA[2], voffB[2];
#pragma unroll
    for (int i = 0; i < 2; ++i) { int R, C; stage_rc(tid * 16 + i * 8192, R, C); const int Rb = Epi::PERM ? ((R & ~31) + perm32(R & 31)) : R;
        voffA[i] = (unsigned)(R * K + C) * 2u; voffB[i] = (unsigned)(Rb * K + C) * 2u; }
    const size_t kstep = (size_t)(BK * 2);
    const size_t hstep = (size_t)HALF * K * 2;
    const size_t tstep = 2 * hstep;
    const unsigned ldsw = (unsigned)wid * 1024u;
    const int aoff = lds_byte(wr * 64 + fr, fq * 8), boff = lds_byte(wc * 32 + fr, fq * 8);
#define PG8_SA(b, h) (((b) * 2 + (h)) * HTB)
#define PG8_SB(b, h) ((4 + (b) * 2 + (h)) * HTB)
#define PG8_STAGE(bufoff, gbase, voff) do { _Pragma("unroll") for (int _i = 0; _i < 2; ++_i) \
        __builtin_amdgcn_global_load_lds((const unsigned*)((const char*)(gbase) + (voff)[_i]), (LAS unsigned*)(lds + (bufoff) + ldsw + _i * 8192), 16, 0, 0); } while (0)
#define PG8_LDA(dst, b, h) do { _Pragma("unroll") for (int m = 0; m < 4; ++m) _Pragma("unroll") for (int k = 0; k < 2; ++k) dst[m][k] = *(const LAS bf16x8*)(lds + PG8_SA(b, h) + aoff + m * 2048 + k * 1024); } while (0)
#define PG8_LDB(dst, b, h) do { _Pragma("unroll") for (int n = 0; n < 2; ++n) _Pragma("unroll") for (int k = 0; k < 2; ++k) dst[n][k] = *(const LAS bf16x8*)(lds + PG8_SB(b, h) + boff + n * 2048 + k * 1024); } while (0)
#define PG8_MMA(ai, bj, At, Bt) do { __builtin_amdgcn_s_setprio(1); _Pragma("unroll") for (int m = 0; m < 4; ++m) _Pragma("unroll") for (int n = 0; n < 2; ++n) _Pragma("unroll") for (int k = 0; k < 2; ++k) \
        acc[ai][bj][m][n] = __builtin_amdgcn_mfma_f32_16x16x32_bf16(Bt[n][k], At[m][k], acc[ai][bj][m][n], 0, 0, 0); __builtin_amdgcn_s_setprio(0); } while (0)
#define PG8_WAIT_V(n) asm volatile("s_waitcnt vmcnt(" #n ")" ::: "memory")
#define PG8_WAIT_L(n) asm volatile("s_waitcnt lgkmcnt(" #n ")" ::: "memory")
#define PG8_BAR __builtin_amdgcn_s_barrier()
#define PG8_SCHED __builtin_amdgcn_sched_barrier(0)
    Unit cur, nxt; int ui = 0;
    if (!S.next(0, cur)) return;
    f32x4 acc[2][2][4][2];
#pragma unroll
    for (int a = 0; a < 2; ++a)
#pragma unroll
        for (int b = 0; b < 2; ++b)
#pragma unroll
            for (int m = 0; m < 4; ++m)
#pragma unroll
                for (int n = 0; n < 2; ++n) acc[a][b][m][n] = (f32x4){0.f, 0.f, 0.f, 0.f};
    bf16x8 At[4][2], B0[2][2], B1[2][2];
    const char* cA = (const char*)g.A + (size_t)cur.pm * tstep; const char* cB = (const char*)g.Bt + (size_t)cur.pn * tstep;
    PG8_STAGE(PG8_SB(0, 0), cB, voffB); PG8_STAGE(PG8_SB(0, 1), cB + hstep, voffB); PG8_STAGE(PG8_SA(0, 0), cA, voffA); PG8_STAGE(PG8_SA(0, 1), cA + hstep, voffA);
    if (wr == 1) PG8_BAR;
    PG8_WAIT_V(2); PG8_BAR;
    PG8_STAGE(PG8_SB(1, 0), cB + kstep, voffB); PG8_STAGE(PG8_SA(1, 0), cA + kstep, voffA); PG8_STAGE(PG8_SB(1, 1), cB + hstep + kstep, voffB);
    PG8_WAIT_V(6); PG8_BAR;
    for (;;) {
        const bool has_next = S.next(ui + 1, nxt);
        const char* nA = has_next ? (const char*)g.A + (size_t)nxt.pm * tstep : cA; const char* nB = has_next ? (const char*)g.Bt + (size_t)nxt.pn * tstep : cB;
        for (int t = 0; t < nt; t += 2) {
            const bool last = (t == nt - 2);
            const char* a1 = cA + (size_t)(t + 1) * kstep;
            const char* a2 = last ? nA : cA + (size_t)(t + 2) * kstep; const char* b2 = last ? nB : cB + (size_t)(t + 2) * kstep;
            const char* a3 = a2 + kstep; const char* b3 = b2 + kstep;
            PG8_LDB(B0, 0, 0); PG8_LDB(B1, 0, 1); PG8_SCHED; PG8_LDA(At, 0, 0); PG8_STAGE(PG8_SA(1, 1), a1 + hstep, voffA);
            PG8_WAIT_V(8); PG8_WAIT_L(0); PG8_BAR; PG8_MMA(0, 0, At, B0); PG8_MMA(0, 1, At, B1); PG8_BAR; PG8_SCHED;
            PG8_LDA(At, 0, 1); PG8_STAGE(PG8_SB(0, 0), b2, voffB); PG8_STAGE(PG8_SB(0, 1), b2 + hstep, voffB); PG8_STAGE(PG8_SA(0, 0), a2, voffA);
            PG8_WAIT_V(8); PG8_WAIT_L(0); PG8_BAR; PG8_MMA(1, 0, At, B0); PG8_MMA(1, 1, At, B1); PG8_BAR; PG8_SCHED;
            PG8_LDB(B0, 1, 0); PG8_LDB(B1, 1, 1); PG8_SCHED; PG8_LDA(At, 1, 0); PG8_STAGE(PG8_SA(0, 1), a2 + hstep, voffA);
            PG8_WAIT_V(8); PG8_WAIT_L(0); PG8_BAR; PG8_MMA(0, 0, At, B0); PG8_MMA(0, 1, At, B1); PG8_BAR; PG8_SCHED;
            PG8_LDA(At, 1, 1); PG8_STAGE(PG8_SB(1, 0), b3, voffB); PG8_STAGE(PG8_SB(1, 1), b3 + hstep, voffB); PG8_STAGE(PG8_SA(1, 0), a3, voffA);
            PG8_WAIT_V(8); PG8_WAIT_L(0); PG8_BAR; PG8_MMA(1, 0, At, B0); PG8_MMA(1, 1, At, B1); PG8_BAR; PG8_SCHED;
        }
        if constexpr (ALIGN_EPI) { if (wr == 0) PG8_BAR; }
        E(acc, cur, wr, wc, fr, fq);
        if (!has_next) break;
#pragma unroll
        for (int a = 0; a < 2; ++a)
#pragma unroll
            for (int b = 0; b < 2; ++b)
#pragma unroll
                for (int m = 0; m < 4; ++m)
#pragma unroll
                    for (int n = 0; n < 2; ++n) acc[a][b][m][n] = (f32x4){0.f, 0.f, 0.f, 0.f};
        cur = nxt; cA = nA; cB = nB; ++ui;
        if constexpr (ALIGN_EPI) { if (wr == 1) PG8_BAR; }
    }
    PG8_WAIT_V(0);
    if constexpr (!ALIGN_EPI) { if (wr == 0) PG8_BAR; }
    PG8_BAR;
#undef PG8_SA
#undef PG8_SB
#undef PG8_STAGE
#undef PG8_LDA
#undef PG8_LDB
#undef PG8_MMA
#undef PG8_WAIT_V
#undef PG8_WAIT_L
#undef PG8_BAR
#undef PG8_SCHED
}
}
using pg8::cvt_pk_bf16;

__device__ __forceinline__ float bf_lo(unsigned w) { return __uint_as_float(w << 16); }
__device__ __forceinline__ float bf_hi(unsigned w) { return __uint_as_float(w & 0xffff0000u); }
__device__ __forceinline__ float wave_sum(float v) {
#pragma unroll
    for (int o = 1; o < 64; o <<= 1) v += __shfl_xor(v, o);
    return v;
}
#define LDS_WAIT() asm volatile("s_waitcnt lgkmcnt(0)" ::: "memory")

struct Args { const float* in[23]; float* out; unsigned char* ws; int lo, hi; };

__device__ __forceinline__ void p0_transpose_item(const float* W, const float* gain, int K, int N, bf16_t* WT, LAS float* scr, int item, int lane) {
    const int nblk = N / 32, kb = item / nblk, nb = item % nblk, k0 = 64 * kb, n0 = 32 * nb;
#pragma unroll 8
    for (int i = 0; i < 32; ++i) { const int kk = 2 * i + (lane >> 5); const float gk = gain ? gain[k0 + kk] : 1.0f; scr[kk * 33 + (lane & 31)] = W[(size_t)(k0 + kk) * N + n0 + (lane & 31)] * gk; }
    LDS_WAIT(); asm volatile("" ::: "memory");
    const int c = lane & 7;
#pragma unroll
    for (int j = 0; j < 4; ++j) { const int n = (lane >> 3) + 8 * j; const LAS float* s = scr + (8 * c) * 33 + n;
        u32x4 o; o.x = cvt_pk_bf16(s[0 * 33], s[1 * 33]); o.y = cvt_pk_bf16(s[2 * 33], s[3 * 33]); o.z = cvt_pk_bf16(s[4 * 33], s[5 * 33]); o.w = cvt_pk_bf16(s[6 * 33], s[7 * 33]);
        *(u32x4*)(WT + (size_t)(n0 + n) * K + k0 + 8 * c) = o; }
    LDS_WAIT(); asm volatile("" ::: "memory");
}

template <bool PASS2>
__device__ __forceinline__ void a_unit(int u, int lane, const bf16_t* XR, const bf16_t* G, bf16_t* Y, float* AGG, const float* CARRY,
                                       const float* conv_w, const float* conv_b, const bf16_t* GW, const float* ga_b, const float* gx_b, const float* lam) {
    const int h = u & 15, cn = u >> 4, row0 = cn * 64;
    const bool first = (cn & 127) == 0;
    const int m = lane & 15, q = lane >> 4;
    const int tl = 16 * (m >> 2) + (m & 3);
    bf16x8 Af[4][3];
#pragma unroll
    for (int ks = 0; ks < 3; ++ks) {
        const int kc0 = 32 * ks + 8 * q; const bool kval = kc0 < HD;
        f32x4 w[4][2], bb[2];
#pragma unroll
        for (int k = 0; k < 4; ++k) { w[k][0] = (f32x4){0.f, 0.f, 0.f, 0.f}; w[k][1] = w[k][0]; }
        bb[0] = (f32x4){0.f, 0.f, 0.f, 0.f}; bb[1] = bb[0];
        if (kval) {
#pragma unroll
            for (int k = 0; k < 4; ++k) { const float* p = conv_w + k * DR + HD * h + kc0; w[k][0] = *(const f32x4*)p; w[k][1] = *(const f32x4*)(p + 4); }
            bb[0] = *(const f32x4*)(conv_b + HD * h + kc0); bb[1] = *(const f32x4*)(conv_b + HD * h + kc0 + 4);
        }
#pragma unroll
        for (int rt = 0; rt < 4; ++rt) {
            f32x4 a0 = bb[0], a1 = bb[1];
#pragma unroll
            for (int k = 0; k < 4; ++k) {
                const int t = tl + 4 * rt - 3 + k;
                u32x4 xv = (u32x4){0u, 0u, 0u, 0u};
                if (kval && !(first && t < 0)) xv = *(const u32x4*)(XR + (long)(row0 + t) * DR + HD * h + kc0);
                a0[0] += w[k][0][0] * bf_lo(xv.x); a0[1] += w[k][0][1] * bf_hi(xv.x); a0[2] += w[k][0][2] * bf_lo(xv.y); a0[3] += w[k][0][3] * bf_hi(xv.y);
                a1[0] += w[k][1][0] * bf_lo(xv.z); a1[1] += w[k][1][1] * bf_hi(xv.z); a1[2] += w[k][1][2] * bf_lo(xv.w); a1[3] += w[k][1][3] * bf_hi(xv.w);
            }
            u32x4 pk; pk.x = cvt_pk_bf16(a0[0], a0[1]); pk.y = cvt_pk_bf16(a0[2], a0[3]); pk.z = cvt_pk_bf16(a1[0], a1[1]); pk.w = cvt_pk_bf16(a1[2], a1[3]);
            Af[rt][ks] = __builtin_bit_cast(bf16x8, pk);
        }
    }
#pragma unroll 1
    for (int nt = 0; nt < 5; ++nt) {
        const int c = HD * h + 16 * nt + m;
        bf16x8 Ba[3], Bx[3];
#pragma unroll
        for (int ks = 0; ks < 3; ++ks) {
            Ba[ks] = *(const bf16x8*)(GW + ((size_t)((h * 2 + 0) * HD + 16 * nt + m)) * 96 + 32 * ks + 8 * q);
            Bx[ks] = *(const bf16x8*)(GW + ((size_t)((h * 2 + 1) * HD + 16 * nt + m)) * 96 + 32 * ks + 8 * q);
        }
        bf16x8 Iq;
#pragma unroll
        for (int j = 0; j < 8; ++j) Iq[j] = (8 * q + j == 16 * (nt & 1) + m) ? (short)0x3F80 : (short)0;
        f32x4 ar[4], ax[4], ac[4];
#pragma unroll
        for (int rt = 0; rt < 4; ++rt) {
            ar[rt] = (f32x4){0.f, 0.f, 0.f, 0.f}; ax[rt] = ar[rt]; ac[rt] = ar[rt];
#pragma unroll
            for (int ks = 0; ks < 3; ++ks) {
                ar[rt] = __builtin_amdgcn_mfma_f32_16x16x32_bf16(Af[rt][ks], Ba[ks], ar[rt], 0, 0, 0);
                ax[rt] = __builtin_amdgcn_mfma_f32_16x16x32_bf16(Af[rt][ks], Bx[ks], ax[rt], 0, 0, 0);
            }
            const bf16x8 Asel = (nt < 2) ? Af[rt][0] : ((nt < 4) ? Af[rt][1] : Af[rt][2]);
            ac[rt] = __builtin_amdgcn_mfma_f32_16x16x32_bf16(Asel, Iq, ac[rt], 0, 0, 0);
        }
        const float ba = ga_b[c], bx = gx_b[c];
        const float kc = -8.0f * log1pf(__expf(-lam[c])) * LOG2E;
        float hl = 0.f, ca = 1.f; float hs[16], cs[16];
#pragma unroll
        for (int rt = 0; rt < 4; ++rt)
#pragma unroll
            for (int i = 0; i < 4; ++i) {
                const float r = pg8::sigmoidf_(ar[rt][i] + ba), ig = pg8::sigmoidf_(ax[rt][i] + bx);
                const float a = pg8::fast_exp2(r * kc);
                const float mult = __builtin_amdgcn_sqrtf(fmaxf(1.0f - a * a, 0.f));
                const float uu = mult * ig * ac[rt][i];
                hl = a * hl + uu; ca *= a;
                if (PASS2) { hs[4 * rt + i] = hl; cs[4 * rt + i] = ca; }
            }
        const float A0 = __shfl(ca, m), H0 = __shfl(hl, m), A1 = __shfl(ca, m + 16), H1 = __shfl(hl, m + 16), A2 = __shfl(ca, m + 32), H2 = __shfl(hl, m + 32);
        if (!PASS2) {
            const float A3 = __shfl(ca, m + 48), H3 = __shfl(hl, m + 48);
            float s = H0; s = A1 * s + H1; s = A2 * s + H2; s = A3 * s + H3;
            const float P = (A0 * A1) * (A2 * A3);
            if (q == 0) *(f32x2*)(AGG + ((size_t)cn * DR + c) * 2) = (f32x2){P, s};
        } else {
            const float s0 = CARRY[(size_t)cn * DR + c];
            const float s1 = A0 * s0 + H0, s2 = A1 * s1 + H1, s3 = A2 * s2 + H2;
            const float sq = q == 0 ? s0 : (q == 1 ? s1 : (q == 2 ? s2 : s3));
#pragma unroll
            for (int st = 0; st < 16; ++st) {
                const size_t off = (size_t)(row0 + 16 * q + st) * DR + c;
                const float hv = hs[st] + cs[st] * sq;
                const float gv = __uint_as_float((unsigned)G[off] << 16);
                Y[off] = (bf16_t)(cvt_pk_bf16(hv * gv, 0.f) & 0xffffu);
            }
        }
    }
}

constexpr int LDV = 136;
__device__ __forceinline__ void sgu_unit(LAS unsigned char* lds, int u, int tid, int lane, int wave, const bf16_t* U, const bf16_t* V, bf16_t* Y,
                                         const float* ssv, const float* ng, const bf16_t* WSb, const float* sbias) {
    const int g = u & 7, cn = u >> 3, row0 = cn * 128;
    LAS bf16_t* vt = (LAS bf16_t*)lds;
    {
        const int c0 = 8 * (tid & 15);
        const f32x4 g0 = *(const f32x4*)(ng + g * 128 + c0), g1 = *(const f32x4*)(ng + g * 128 + c0 + 4);
#pragma unroll
        for (int i = 0; i < 2; ++i) {
            const int s = 2 * ((tid >> 4) + 32 * i);
            const u32x4 va = *(const u32x4*)(V + (size_t)(row0 + s) * D + g * 128 + c0), vb = *(const u32x4*)(V + (size_t)(row0 + s + 1) * D + g * 128 + c0);
            float sa = 0.f, sb = 0.f;
#pragma unroll
            for (int k = 0; k < 4; ++k) { const f32x4 pa = *(const f32x4*)(ssv + (size_t)(row0 + s) * 16 + 4 * k), pb = *(const f32x4*)(ssv + (size_t)(row0 + s + 1) * 16 + 4 * k);
                sa += (pa[0] + pa[1]) + (pa[2] + pa[3]); sb += (pb[0] + pb[1]) + (pb[2] + pb[3]); }
            const float ra = __builtin_amdgcn_rsqf(sa * (1.0f / 1024.0f) + EPS), rb = __builtin_amdgcn_rsqf(sb * (1.0f / 1024.0f) + EPS);
            LAS unsigned* dst = (LAS unsigned*)(vt + s);
            dst[(c0 + 0) * (LDV / 2)] = cvt_pk_bf16(bf_lo(va.x) * ra * g0[0], bf_lo(vb.x) * rb * g0[0]);
            dst[(c0 + 1) * (LDV / 2)] = cvt_pk_bf16(bf_hi(va.x) * ra * g0[1], bf_hi(vb.x) * rb * g0[1]);
            dst[(c0 + 2) * (LDV / 2)] = cvt_pk_bf16(bf_lo(va.y) * ra * g0[2], bf_lo(vb.y) * rb * g0[2]);
            dst[(c0 + 3) * (LDV / 2)] = cvt_pk_bf16(bf_hi(va.y) * ra * g0[3], bf_hi(vb.y) * rb * g0[3]);
            dst[(c0 + 4) * (LDV / 2)] = cvt_pk_bf16(bf_lo(va.z) * ra * g1[0], bf_lo(vb.z) * rb * g1[0]);
            dst[(c0 + 5) * (LDV / 2)] = cvt_pk_bf16(bf_hi(va.z) * ra * g1[1], bf_hi(vb.z) * rb * g1[1]);
            dst[(c0 + 6) * (LDV / 2)] = cvt_pk_bf16(bf_lo(va.w) * ra * g1[2], bf_lo(vb.w) * rb * g1[2]);
            dst[(c0 + 7) * (LDV / 2)] = cvt_pk_bf16(bf_hi(va.w) * ra * g1[3], bf_hi(vb.w) * rb * g1[3]);
        }
    }
    __syncthreads();
    {
        const int m = lane & 15, q = lane >> 4, t = 16 * wave + m, kmax = wave >> 1;
        bf16x8 Bw[4];
#pragma unroll
        for (int ks = 0; ks < 4; ++ks) { Bw[ks] = (bf16x8){0, 0, 0, 0, 0, 0, 0, 0}; if (ks <= kmax) Bw[ks] = *(const bf16x8*)(WSb + ((size_t)(g * 128 + t)) * 128 + 32 * ks + 8 * q); }
        const float bias = sbias[g * 128 + t];
#pragma unroll
        for (int p = 0; p < 4; ++p) {
            f32x4 ac[2];
#pragma unroll
            for (int e = 0; e < 2; ++e) {
                ac[e] = (f32x4){0.f, 0.f, 0.f, 0.f};
                const int cc = 32 * p + 8 * (m >> 2) + 4 * e + (m & 3);
#pragma unroll
                for (int ks = 0; ks < 4; ++ks) if (ks <= kmax) {
                    const bf16x8 Afr = *(const LAS bf16x8*)(vt + cc * LDV + 32 * ks + 8 * q);
                    ac[e] = __builtin_amdgcn_mfma_f32_16x16x32_bf16(Afr, Bw[ks], ac[e], 0, 0, 0);
                }
            }
            const size_t off = (size_t)(row0 + t) * D + g * 128 + 32 * p + 8 * q;
            const u32x4 uv = *(const u32x4*)(U + off);
            u32x4 o;
            o.x = cvt_pk_bf16(bf_lo(uv.x) * (ac[0][0] + bias), bf_hi(uv.x) * (ac[0][1] + bias));
            o.y = cvt_pk_bf16(bf_lo(uv.y) * (ac[0][2] + bias), bf_hi(uv.y) * (ac[0][3] + bias));
            o.z = cvt_pk_bf16(bf_lo(uv.z) * (ac[1][0] + bias), bf_hi(uv.z) * (ac[1][1] + bias));
            o.w = cvt_pk_bf16(bf_lo(uv.w) * (ac[1][2] + bias), bf_hi(uv.w) * (ac[1][3] + bias));
            *(u32x4*)(Y + off) = o;
        }
    }
    __syncthreads();
}

__global__ void __launch_bounds__(512, 2) trunk_fwd(Args args) {
    extern __shared__ __attribute__((aligned(16))) unsigned char lds_raw[];
    LAS unsigned char* lds = (LAS unsigned char*)lds_raw;
    const int G_ = gridDim.x, bx = blockIdx.x;
    const int NGW = G_ * 8, NGT = G_ * 512;
#define PHASE_IDS() int tid = threadIdx.x; asm volatile("" : "+v"(tid)); const int lane = tid & 63, wave = __builtin_amdgcn_readfirstlane(tid >> 6), gw = bx * 8 + wave, gtid = bx * 512 + tid; (void)lane; (void)wave; (void)gw; (void)gtid
    unsigned char* ws = args.ws;
    float* X = args.out;
    float* SSP = (float*)(ws + WS_SSP);
    bf16_t* XB = (bf16_t*)(ws + WS_XB);
    unsigned char* BIG = ws + WS_BIG;
    const int lo = args.lo, hi = args.hi;
    int ph = 0;
#define RUN() (ph >= lo && ph < hi)
#define SEAM() do { ++ph; if (ph > lo && ph < hi) cg::this_grid().sync(); } while (0)

    if (((PHMASK >> 0) & 1) && RUN()) { PHASE_IDS();
        LAS float* scr = (LAS float*)(lds + wave * 16384);
#pragma unroll 1
        for (int mi = 0; mi < 16; ++mi) {
            const float* W; const float* gain = nullptr; bf16_t* WT; int K, N;
            if (mi < 2)        { W = args.in[4] + (size_t)mi * D * 2 * DR; gain = args.in[1] + (size_t)(3 * mi) * D; WT = (bf16_t*)(ws + W_AWIN) + (size_t)mi * D * 2 * DR; K = D; N = 2 * DR; }
            else if (mi < 4)   { const int j = mi - 2; W = args.in[12] + (size_t)j * DR * D; WT = (bf16_t*)(ws + W_AWOUT) + (size_t)j * DR * D; K = DR; N = D; }
            else if (mi == 4)  { W = args.in[13]; gain = args.in[1] + 1 * D; WT = (bf16_t*)(ws + W_BWIN); K = D; N = 2 * D; }
            else if (mi == 5)  { W = args.in[17]; WT = (bf16_t*)(ws + W_BWOUT); K = D; N = D; }
            else if (mi == 6)  { W = args.in[18]; gain = args.in[1] + 2 * D; WT = (bf16_t*)(ws + W_CWIN); K = D; N = 3 * D; }
            else if (mi == 7)  { W = args.in[20]; WT = (bf16_t*)(ws + W_CWOUT); K = D; N = D; }
            else if (mi < 12)  { const int i = mi - 8; W = args.in[21] + (size_t)i * D * FF; gain = args.in[2] + (size_t)i * D; WT = (bf16_t*)(ws + W_W1) + (size_t)i * D * FF; K = D; N = FF; }
            else               { const int i = mi - 12; W = args.in[22] + (size_t)i * FF * D; WT = (bf16_t*)(ws + W_W2) + (size_t)i * FF * D; K = FF; N = D; }
            const int nitems = (K / 64) * (N / 32);
#pragma unroll 1
            for (int it = gw; it < nitems; it += NGW) p0_transpose_item(W, gain, K, N, WT, scr, it, lane);
        }
        for (int id = gtid; id < 2 * NH * 2 * HD * 12; id += NGT) {
            const int k8 = id % 12, n = (id / 12) % HD, qq = (id / (12 * HD)) & 1, jh = id / (12 * HD * 2);
            const float* Wg = (qq ? args.in[9] : args.in[7]) + (size_t)jh * HD * HD;
            float v[8];
#pragma unroll
            for (int j = 0; j < 8; ++j) { const int k = 8 * k8 + j; v[j] = (k < HD) ? Wg[k * HD + n] : 0.f; }
            u32x4 o; o.x = cvt_pk_bf16(v[0], v[1]); o.y = cvt_pk_bf16(v[2], v[3]); o.z = cvt_pk_bf16(v[4], v[5]); o.w = cvt_pk_bf16(v[6], v[7]);
            *(u32x4*)((bf16_t*)(ws + WS_GW) + (size_t)id * 8) = o;
        }
        for (int id = gtid; id < 8 * 128 * 16; id += NGT) {
            const int s8 = id & 15, t = (id >> 4) & 127;
            const float* p = args.in[15] + (size_t)id * 8; float v[8];
#pragma unroll
            for (int j = 0; j < 8; ++j) v[j] = (8 * s8 + j <= t) ? p[j] : 0.f;
            u32x4 o; o.x = cvt_pk_bf16(v[0], v[1]); o.y = cvt_pk_bf16(v[2], v[3]); o.z = cvt_pk_bf16(v[4], v[5]); o.w = cvt_pk_bf16(v[6], v[7]);
            *(u32x4*)((bf16_t*)(ws + WS_WSB) + (size_t)id * 8) = o;
        }
        const float* x = args.in[0];
        for (int r = gw; r < M; r += NGW) {
            const f32x4* xr = (const f32x4*)(x + (size_t)r * D) + lane; float s = 0.f;
            unsigned long long* o8 = (unsigned long long*)(XB + (size_t)r * D) + lane;
#pragma unroll
            for (int j = 0; j < 4; ++j) { const f32x4 v = xr[64 * j]; s += (v[0] * v[0] + v[1] * v[1]) + (v[2] * v[2] + v[3] * v[3]);
                o8[64 * j] = (unsigned long long)cvt_pk_bf16(v[0], v[1]) | ((unsigned long long)cvt_pk_bf16(v[2], v[3]) << 32); }
            s = wave_sum(s);
            if (lane < 16) SSP[(size_t)r * 16 + lane] = (lane == 0) ? s : 0.f;
        }
    }
    SEAM();

#pragma unroll 1
    for (int L = 0; L < 4; ++L) {
        const int kind = L % 3, j = L / 3;
        const float* xbase = (L == 0) ? args.in[0] : X;
        const bf16_t* Ymix; const bf16_t* Wout; int Kout;
        if (kind == 0) {
            bf16_t* Gb = (bf16_t*)(BIG + A_G); bf16_t* XRb = (bf16_t*)(BIG + A_XR); bf16_t* Yb = (bf16_t*)(BIG + A_Y);
            float* AGG = (float*)(BIG + A_AGG); float* CARRY = (float*)(BIG + A_CARRY);
            if (((PHMASK >> 1) & 1) && RUN()) { PHASE_IDS();
                pg8::Gemm g{XB, (const bf16_t*)(ws + W_AWIN) + (size_t)j * D * 2 * DR, M, 2 * DR, D}; pg8::StaticOrder S; S.init(M, 2 * DR, G_, bx);
                pg8::EpiAct<0> E{Gb, DR, DR, (size_t)(A_XR - A_G) / 2, SSP, nullptr};
                pg8::gemm_phase<pg8::EpiAct<0>, pg8::StaticOrder>(lds, g, S, E);
            }
            SEAM();
            const float* cw = args.in[5] + (size_t)j * 4 * DR; const float* cb = args.in[6] + (size_t)j * DR;
            const bf16_t* GWl = (const bf16_t*)(ws + WS_GW) + (size_t)j * NH * 2 * HD * 96;
            const float* gab = args.in[8] + (size_t)j * DR; const float* gxb = args.in[10] + (size_t)j * DR; const float* lam = args.in[11] + (size_t)j * DR;
            if (((PHMASK >> 2) & 1) && RUN()) { PHASE_IDS();
#pragma unroll 1
                for (int u = gw; u < 256 * NH; u += NGW) a_unit<false>(u, lane, XRb, Gb, Yb, AGG, CARRY, cw, cb, GWl, gab, gxb, lam);
            }
            SEAM();
            if (((PHMASK >> 3) & 1) && RUN()) { PHASE_IDS();
                if (gtid < 2 * DR) {
                    const int b = gtid / DR, c = gtid % DR; float s = 0.f;
#pragma unroll 8
                    for (int n = 0; n < 128; ++n) { const size_t o = (size_t)(b * 128 + n) * DR + c; CARRY[o] = s; const f32x2 ph_ = *(const f32x2*)(AGG + o * 2); s = ph_[0] * s + ph_[1]; }
                }
            }
            SEAM();
            if (((PHMASK >> 4) & 1) && RUN()) { PHASE_IDS();
#pragma unroll 1
                for (int u = gw; u < 256 * NH; u += NGW) a_unit<true>(u, lane, XRb, Gb, Yb, AGG, CARRY, cw, cb, GWl, gab, gxb, lam);
            }
            SEAM();
            Ymix = Yb; Wout = (const bf16_t*)(ws + W_AWOUT) + (size_t)j * DR * D; Kout = DR;
        } else if (kind == 1) {
            bf16_t* Ub = (bf16_t*)(BIG + B_U); bf16_t* Vb = (bf16_t*)(BIG + B_V); bf16_t* Yb = (bf16_t*)(BIG + B_Y); float* SSV = (float*)(BIG + B_SSV);
            if (((PHMASK >> 5) & 1) && RUN()) { PHASE_IDS();
                pg8::Gemm g{XB, (const bf16_t*)(ws + W_BWIN), M, 2 * D, D}; pg8::StaticOrder S; S.init(M, 2 * D, G_, bx);
                pg8::EpiAct<2> E{Ub, D, D, (size_t)(B_V - B_U) / 2, SSP, SSV};
                pg8::gemm_phase<pg8::EpiAct<2>, pg8::StaticOrder>(lds, g, S, E);
            }
            SEAM();
            if (((PHMASK >> 6) & 1) && RUN()) { PHASE_IDS();
#pragma unroll 1
                for (int u = bx; u < 128 * 8; u += G_) sgu_unit(lds, u, tid, lane, wave, Ub, Vb, Yb, SSV, args.in[14], (const bf16_t*)(ws + WS_WSB), args.in[16]);
            }
            SEAM();
            Ymix = Yb; Wout = (const bf16_t*)(ws + W_BWOUT); Kout = D;
        } else {
            bf16_t* GCX = (bf16_t*)(BIG + C_GCX); bf16_t* Yb = (bf16_t*)(BIG + C_Y);
            if (((PHMASK >> 7) & 1) && RUN()) { PHASE_IDS();
                pg8::Gemm g{XB, (const bf16_t*)(ws + W_CWIN), M, 3 * D, D}; pg8::StaticOrder S; S.init(M, 3 * D, G_, bx);
                pg8::EpiAct<3> E{GCX, 3 * D, 0, 0, SSP, nullptr};
                pg8::gemm_phase<pg8::EpiAct<3>, pg8::StaticOrder>(lds, g, S, E);
            }
            SEAM();
            if (((PHMASK >> 8) & 1) && RUN()) { PHASE_IDS();
                const float* cw = args.in[19];
                for (int id = gtid; id < (M / 16) * 128; id += NGT) {
                    const int cgp = id & 127, r = id >> 7, c0 = 8 * cgp, rowb = r * 16;
                    f32x4 w[3][2];
#pragma unroll
                    for (int k = 0; k < 3; ++k) { w[k][0] = *(const f32x4*)(cw + k * D + c0); w[k][1] = *(const f32x4*)(cw + k * D + c0 + 4); }
                    float p2[8], p1[8];
#pragma unroll
                    for (int jj = 0; jj < 8; ++jj) { p2[jj] = 0.f; p1[jj] = 0.f; }
                    if ((rowb & (SEQ - 1)) != 0) {
                        const u32x4 ga = *(const u32x4*)(GCX + (size_t)(rowb - 2) * 3 * D + D + c0), xa = *(const u32x4*)(GCX + (size_t)(rowb - 2) * 3 * D + 2 * D + c0);
                        const u32x4 gb_ = *(const u32x4*)(GCX + (size_t)(rowb - 1) * 3 * D + D + c0), xb_ = *(const u32x4*)(GCX + (size_t)(rowb - 1) * 3 * D + 2 * D + c0);
                        p2[0] = bf_lo(ga.x) * bf_lo(xa.x); p2[1] = bf_hi(ga.x) * bf_hi(xa.x); p2[2] = bf_lo(ga.y) * bf_lo(xa.y); p2[3] = bf_hi(ga.y) * bf_hi(xa.y);
                        p2[4] = bf_lo(ga.z) * bf_lo(xa.z); p2[5] = bf_hi(ga.z) * bf_hi(xa.z); p2[6] = bf_lo(ga.w) * bf_lo(xa.w); p2[7] = bf_hi(ga.w) * bf_hi(xa.w);
                        p1[0] = bf_lo(gb_.x) * bf_lo(xb_.x); p1[1] = bf_hi(gb_.x) * bf_hi(xb_.x); p1[2] = bf_lo(gb_.y) * bf_lo(xb_.y); p1[3] = bf_hi(gb_.y) * bf_hi(xb_.y);
                        p1[4] = bf_lo(gb_.z) * bf_lo(xb_.z); p1[5] = bf_hi(gb_.z) * bf_hi(xb_.z); p1[6] = bf_lo(gb_.w) * bf_lo(xb_.w); p1[7] = bf_hi(gb_.w) * bf_hi(xb_.w);
                    }
#pragma unroll 4
                    for (int t = 0; t < 16; ++t) {
                        const size_t ro = (size_t)(rowb + t) * 3 * D + c0;
                        const u32x4 bb = *(const u32x4*)(GCX + ro), gc = *(const u32x4*)(GCX + ro + D), xv = *(const u32x4*)(GCX + ro + 2 * D);
                        float p0[8], gbv[8];
                        p0[0] = bf_lo(gc.x) * bf_lo(xv.x); p0[1] = bf_hi(gc.x) * bf_hi(xv.x); p0[2] = bf_lo(gc.y) * bf_lo(xv.y); p0[3] = bf_hi(gc.y) * bf_hi(xv.y);
                        p0[4] = bf_lo(gc.z) * bf_lo(xv.z); p0[5] = bf_hi(gc.z) * bf_hi(xv.z); p0[6] = bf_lo(gc.w) * bf_lo(xv.w); p0[7] = bf_hi(gc.w) * bf_hi(xv.w);
                        gbv[0] = bf_lo(bb.x); gbv[1] = bf_hi(bb.x); gbv[2] = bf_lo(bb.y); gbv[3] = bf_hi(bb.y); gbv[4] = bf_lo(bb.z); gbv[5] = bf_hi(bb.z); gbv[6] = bf_lo(bb.w); gbv[7] = bf_hi(bb.w);
                        float y[8];
#pragma unroll
                        for (int jj = 0; jj < 8; ++jj) { y[jj] = gbv[jj] * (w[0][jj >> 2][jj & 3] * p2[jj] + w[1][jj >> 2][jj & 3] * p1[jj] + w[2][jj >> 2][jj & 3] * p0[jj]); p2[jj] = p1[jj]; p1[jj] = p0[jj]; }
                        u32x4 o; o.x = cvt_pk_bf16(y[0], y[1]); o.y = cvt_pk_bf16(y[2], y[3]); o.z = cvt_pk_bf16(y[4], y[5]); o.w = cvt_pk_bf16(y[6], y[7]);
                        *(u32x4*)(Yb + (size_t)(rowb + t) * D + c0) = o;
                    }
                }
            }
            SEAM();
            Ymix = Yb; Wout = (const bf16_t*)(ws + W_CWOUT); Kout = D;
        }
        if (((PHMASK >> 9) & 1) && RUN()) { PHASE_IDS();
            pg8::Gemm g{Ymix, Wout, M, D, Kout}; pg8::StaticOrder S; S.init(M, D, G_, bx);
            pg8::EpiRes E{xbase, X, XB, SSP};
            pg8::gemm_phase<pg8::EpiRes, pg8::StaticOrder>(lds, g, S, E);
        }
        SEAM();
        if (((PHMASK >> 10) & 1) && RUN()) { PHASE_IDS();
            pg8::Gemm g{XB, (const bf16_t*)(ws + W_W1) + (size_t)L * D * FF, M, FF, D}; pg8::StaticOrder S; S.init(M, FF, G_, bx);
            pg8::EpiAct<1> E{(bf16_t*)BIG, FF, 0, 0, SSP, nullptr};
            pg8::gemm_phase<pg8::EpiAct<1>, pg8::StaticOrder>(lds, g, S, E);
        }
        SEAM();
        if (((PHMASK >> 11) & 1) && RUN()) { PHASE_IDS();
            pg8::Gemm g{(const bf16_t*)BIG, (const bf16_t*)(ws + W_W2) + (size_t)L * FF * D, M, D, FF}; pg8::StaticOrder S; S.init(M, D, G_, bx);
            pg8::EpiRes E{X, X, XB, SSP};
            pg8::gemm_phase<pg8::EpiRes, pg8::StaticOrder>(lds, g, S, E);
        }
        SEAM();
    }
    if (((PHMASK >> 12) & 1) && RUN()) { PHASE_IDS();
        const float* fg = args.in[3];
        for (int r = gw; r < M; r += NGW) {
            float s = (lane < 16) ? SSP[(size_t)r * 16 + lane] : 0.f;
            s = wave_sum(s);
            const float rs = __builtin_amdgcn_rsqf(s * (1.0f / 1024.0f) + EPS);
            f32x4* xr = (f32x4*)(X + (size_t)r * D) + lane; const f32x4* gr = (const f32x4*)fg + lane;
#pragma unroll
            for (int jj = 0; jj < 4; ++jj) { const f32x4 v = xr[64 * jj], gg = gr[64 * jj]; xr[64 * jj] = v * rs * gg; }
        }
    }
#undef RUN
#undef SEAM
}

extern "C" void kernel_launch(void* const* d_in, const int* in_sizes, int n_in, void* d_out, int out_size, void* d_ws, size_t ws_size, hipStream_t stream) {
    static int grid = 0;
    if (grid == 0) {
        if (n_in != 23 || in_sizes[0] != M * D || out_size != M * D || ws_size < WS_END) {
            fprintf(stderr, "kernel_launch: unexpected shapes (n_in %d, in0 %d, out %d, ws %zu < %zu); nothing launched\n", n_in, n_in > 0 ? in_sizes[0] : -1, out_size, ws_size, (size_t)WS_END); grid = -1; return; }
        int dev = 0, cus = 0, per_cu = 0;
        if (hipGetDevice(&dev) != hipSuccess || hipDeviceGetAttribute(&cus, hipDeviceAttributeMultiprocessorCount, dev) != hipSuccess) { grid = -1; return; }
        if (hipFuncSetAttribute((const void*)trunk_fwd, hipFuncAttributeMaxDynamicSharedMemorySize, LDS_BYTES) != hipSuccess) { fprintf(stderr, "kernel_launch: hipFuncSetAttribute failed\n"); grid = -1; return; }
        if (hipOccupancyMaxActiveBlocksPerMultiprocessor(&per_cu, (const void*)trunk_fwd, 512, LDS_BYTES) != hipSuccess || per_cu < 1) { fprintf(stderr, "kernel_launch: occupancy query gave %d\n", per_cu); per_cu = 1; }
        (void)hipGetLastError();
        grid = cus * per_cu;
    }
    if (grid < 0) return;
    Args a{};
    for (int i = 0; i < 23; ++i) a.in[i] = (const float*)d_in[i];
    a.out = (float*)d_out; a.ws = (unsigned char*)d_ws;
#if MK_MULTI
    for (int p = 0; p < NPHASE; ++p) { a.lo = p; a.hi = p + 1; hipLaunchKernelGGL(trunk_fwd, dim3(grid), dim3(512), LDS_BYTES, stream, a); }
#else
    a.lo = 0; a.hi = NPHASE;
    void* kargs[] = {(void*)&a};
    hipError_t e = hipLaunchCooperativeKernel((const void*)trunk_fwd, dim3(grid), dim3(512), kargs, LDS_BYTES, stream);
    if (e != hipSuccess) fprintf(stderr, "kernel_launch: cooperative launch failed: %s (grid %d)\n", hipGetErrorString(e), grid);
#endif
}
```

```cpp
#include <hip/hip_runtime.h>
#include <hip/hip_cooperative_groups.h>
#include <cstdio>
#include <cstdint>
namespace cg = cooperative_groups;

#ifndef PHMASK
#define PHMASK 0xFFFFFFFFu
#endif
#ifndef MK_MULTI
#define MK_MULTI 0
#endif

#define LAS __attribute__((address_space(3)))
typedef unsigned short bf16_t;
typedef short bf16x8 __attribute__((ext_vector_type(8)));
typedef float f32x4 __attribute__((ext_vector_type(4)));
typedef float f32x2 __attribute__((ext_vector_type(2)));
typedef unsigned u32x4 __attribute__((ext_vector_type(4)));
typedef unsigned u32x2 __attribute__((ext_vector_type(2)));

constexpr int SEQ = 8192, M = 2 * SEQ, D = 1024, DR = 1280, FF = 4096, NH = 16, HD = 80;
constexpr float EPS = 1e-6f, LOG2E = 1.4426950408889634f;
constexpr int NPHASE = 26;

constexpr size_t MiB = 1u << 20;
constexpr size_t WS_SSP = 0;
constexpr size_t WS_GW = 1 * MiB;
constexpr size_t WS_BAR = 1 * MiB + 983040;
constexpr size_t WS_WSB = 2 * MiB;
constexpr size_t WS_W = 2 * MiB + 256 * 1024;
constexpr size_t W_AWIN = WS_W, W_AWOUT = WS_W + 10 * MiB, W_BWIN = WS_W + 15 * MiB, W_BWOUT = WS_W + 19 * MiB, W_CWIN = WS_W + 21 * MiB,
                 W_CWOUT = WS_W + 27 * MiB, W_W1 = WS_W + 29 * MiB, W_W2 = WS_W + 61 * MiB;
constexpr size_t WS_XB = WS_W + 93 * MiB;
constexpr size_t WS_BIG = WS_XB + 32 * MiB;
constexpr size_t WS_END = WS_BIG + 128 * MiB;
constexpr size_t A_G = 0, A_XR = 40 * MiB, A_Y = 80 * MiB, A_AGG = 120 * MiB, A_CARRY = 124 * MiB;
constexpr size_t B_U = 0, B_V = 32 * MiB, B_Y = 64 * MiB, B_SSV = 96 * MiB;
constexpr size_t C_GCX = 0, C_Y = 96 * MiB;

constexpr int LDS_BYTES = 147456;

namespace pg8 {
constexpr int BM = 256, BK = 64, HALF = 128, HTB = HALF * BK * 2, STAGE_BYTES = 8 * HTB, NXCD = 8, WGM = 8;
__host__ __device__ __forceinline__ int lds_byte(int r, int c) { const int st = (r >> 4) * 2 + (c >> 5), rr = r & 15, cc = c & 31, ob = rr * 64 + cc * 2; return st * 1024 + (ob ^ (((ob >> 9) & 1) << 5)); }
__host__ __device__ __forceinline__ void stage_rc(int b, int& R, int& C) { const int st = b / 1024, sb = b % 1024, swz = sb ^ (((sb >> 9) & 1) << 5); R = (st >> 1) * 16 + swz / 64; C = (st & 1) * 32 + (swz % 64) / 2; }
__host__ __device__ __forceinline__ int perm32(int rho) { const int n = rho >> 4, i = rho & 15; return 8 * (i >> 2) + 4 * n + (i & 3); }

struct Unit { int pm, pn; };
struct Gemm { const bf16_t* A; const bf16_t* Bt; int M, N, K; };

struct StaticOrder {
    int nM, nN, nwg, G, c;
    __host__ __device__ void init(int M_, int N_, int G_, int c_) { nM = M_ / BM; nN = N_ / BM; nwg = nM * nN; G = G_; c = c_; }
    __host__ __device__ bool next(int i, Unit& u) const {
        const long L = (long)i * G + c; if (L >= nwg) return false;
        int wgid = (int)L; { const int q = nwg / NXCD, r = nwg % NXCD, xcd = wgid % NXCD, off = wgid / NXCD; wgid = (xcd < r ? xcd * (q + 1) : r * (q + 1) + (xcd - r) * q) + off; }
        const int nig = WGM * nN, gid = wgid / nig, fm = gid * WGM, gsz = (nM - fm) < WGM ? (nM - fm) : WGM;
        u.pm = fm + ((wgid % nig) % gsz); u.pn = (wgid % nig) / gsz; return true;
    }
};

__device__ __forceinline__ unsigned cvt_pk_bf16(float lo, float hi) { unsigned r; asm volatile("v_cvt_pk_bf16_f32 %0, %1, %2" : "=v"(r) : "v"(lo), "v"(hi)); return r; }
__device__ __forceinline__ float fast_rcp(float x) { return __builtin_amdgcn_rcpf(x); }
__device__ __forceinline__ float fast_exp2(float x) { return __builtin_amdgcn_exp2f(x); }
__device__ __forceinline__ float sigmoidf_(float z) { return fast_rcp(1.0f + fast_exp2(-LOG2E * z)); }
__device__ __forceinline__ float gelu_tanh(float x) { const float z = x * (1.0f + 0.044715f * x * x); return x * fast_rcp(1.0f + fast_exp2(-2.0f * 0.7978845608028654f * LOG2E * z)); }

__device__ __forceinline__ float row_rs(const float* ssp, int row, int fq) {
    const f32x4 p = *(const f32x4*)(ssp + (size_t)row * 16 + 4 * fq);
    float s = (p[0] + p[1]) + (p[2] + p[3]);
    s += __shfl_xor(s, 16); s += __shfl_xor(s, 32);
    return __builtin_amdgcn_rsqf(s * (1.0f / 1024.0f) + EPS);
}

template <int MODE> struct EpiAct {
    static constexpr bool PERM = true, AFTER_DRAIN = false;
    bf16_t* O; int ldc; int split_cols; size_t split_stride; const float* ssp; float* ssv;
    __device__ __forceinline__ void operator()(const f32x4 (&acc)[2][2][4][2], const Unit& u, int wr, int wc, int fr, int fq) const {
        const int row0 = u.pm * BM + wr * 64 + fr; int colt = u.pn * BM; bf16_t* base = O; int t = 0;
        if (split_cols) { t = colt / split_cols; base += (size_t)t * split_stride; colt -= t * split_cols; }
        const int col0 = colt + wc * 32 + 8 * fq;
#pragma unroll
        for (int ai = 0; ai < 2; ++ai)
#pragma unroll
            for (int m = 0; m < 4; ++m) {
                const int row = row0 + ai * HALF + m * 16;
                const float rs = row_rs(ssp, row, fq);
                bf16_t* rowp = base + (size_t)row * ldc + col0; float vs = 0.f;
#pragma unroll
                for (int bj = 0; bj < 2; ++bj) {
                    f32x4 v0 = acc[ai][bj][m][0] * rs, v1 = acc[ai][bj][m][1] * rs;
                    if (MODE == 0) { if (t == 0) {
#pragma unroll
                        for (int j = 0; j < 4; ++j) { v0[j] = gelu_tanh(v0[j]); v1[j] = gelu_tanh(v1[j]); } } }
                    if (MODE == 1) {
#pragma unroll
                        for (int j = 0; j < 4; ++j) { const float a = fmaxf(v0[j], 0.f), b = fmaxf(v1[j], 0.f); v0[j] = a * a; v1[j] = b * b; } }
                    if (MODE == 2) {
#pragma unroll
                        for (int j = 0; j < 4; ++j) { v0[j] = gelu_tanh(v0[j]); v1[j] = gelu_tanh(v1[j]); }
                        vs += (v0[0] * v0[0] + v0[1] * v0[1]) + (v0[2] * v0[2] + v0[3] * v0[3]) + (v1[0] * v1[0] + v1[1] * v1[1]) + (v1[2] * v1[2] + v1[3] * v1[3]); }
                    u32x4 w; w.x = cvt_pk_bf16(v0[0], v0[1]); w.y = cvt_pk_bf16(v0[2], v0[3]); w.z = cvt_pk_bf16(v1[0], v1[1]); w.w = cvt_pk_bf16(v1[2], v1[3]);
                    *(u32x4*)(rowp + bj * HALF) = w;
                }
                if (MODE == 2) { vs += __shfl_xor(vs, 16); vs += __shfl_xor(vs, 32);
                    if (t == 1 && fq == 0) ssv[(size_t)row * 16 + (u.pn - 4) * 4 + wc] = vs; }
            }
    }
};
struct EpiRes {
    static constexpr bool PERM = true, AFTER_DRAIN = false;
    const float* base; float* out; bf16_t* xb; float* ssp;
    __device__ __forceinline__ void operator()(const f32x4 (&acc)[2][2][4][2], const Unit& u, int wr, int wc, int fr, int fq) const {
        const int row0 = u.pm * BM + wr * 64 + fr, col0 = u.pn * BM + wc * 32 + 8 * fq;
#pragma unroll
        for (int ai = 0; ai < 2; ++ai)
#pragma unroll
            for (int m = 0; m < 4; ++m) {
                const int row = row0 + ai * HALF + m * 16; float ss = 0.f;
#pragma unroll
                for (int bj = 0; bj < 2; ++bj) {
                    const size_t off = (size_t)row * D + col0 + bj * HALF;
                    const f32x4 b0 = *(const f32x4*)(base + off), b1 = *(const f32x4*)(base + off + 4);
                    const f32x4 v0 = acc[ai][bj][m][0] + b0, v1 = acc[ai][bj][m][1] + b1;
                    *(f32x4*)(out + off) = v0; *(f32x4*)(out + off + 4) = v1;
                    ss += (v0[0] * v0[0] + v0[1] * v0[1]) + (v0[2] * v0[2] + v0[3] * v0[3]) + (v1[0] * v1[0] + v1[1] * v1[1]) + (v1[2] * v1[2] + v1[3] * v1[3]);
                    u32x4 w; w.x = cvt_pk_bf16(v0[0], v0[1]); w.y = cvt_pk_bf16(v0[2], v0[3]); w.z = cvt_pk_bf16(v1[0], v1[1]); w.w = cvt_pk_bf16(v1[2], v1[3]);
                    *(u32x4*)(xb + off) = w;
                }
                ss += __shfl_xor(ss, 16); ss += __shfl_xor(ss, 32);
                if (fq == 0) ssp[(size_t)row * 16 + u.pn * 4 + wc] = ss;
            }
    }
};

template <class Epi, class Sched, bool ALIGN_EPI = true>
__device__ __forceinline__ void gemm_phase(LAS unsigned char* lds, const Gemm g, const Sched& S, const Epi& E) {
    int tid_o = threadIdx.x; asm volatile("" : "+v"(tid_o));
    const int tid = tid_o, wid = __builtin_amdgcn_readfirstlane(tid >> 6), lane = tid & 63, wr = wid >> 2, wc = wid & 3, fr = lane & 15, fq = lane >> 4;
    const int K = g.K, nt = K / BK;
    unsigned voffA[2], voffB[2];
#pragma unroll
    for (int i = 0; i < 2; ++i) { int R, C; stage_rc(tid * 16 + i * 8192, R, C); const int Rb = Epi::PERM ? ((R & ~31) + perm32(R & 31)) : R;
        voffA[i] = (unsigned)(R * K + C) * 2u; voffB[i] = (unsigned)(Rb * K + C) * 2u; }
    const size_t kstep = (size_t)(BK * 2);
    const size_t hstep = (size_t)HALF * K * 2;
    const size_t tstep = 2 * hstep;
    const unsigned ldsw = (unsigned)wid * 1024u;
    const int aoff = lds_byte(wr * 64 + fr, fq * 8), boff = lds_byte(wc * 32 + fr, fq * 8);
#define PG8_SA(b, h) (((b) * 2 + (h)) * HTB)
#define PG8_SB(b, h) ((4 + (b) * 2 + (h)) * HTB)
#define PG8_STAGE(bufoff, gbase, voff) do { _Pragma("unroll") for (int _i = 0; _i < 2; ++_i) \
        __builtin_amdgcn_global_load_lds((const unsigned*)((const char*)(gbase) + (voff)[_i]), (LAS unsigned*)(lds + (bufoff) + ldsw + _i * 8192), 16, 0, 0); } while (0)
#define PG8_LDA(dst, b, h) do { _Pragma("unroll") for (int m = 0; m < 4; ++m) _Pragma("unroll") for (int k = 0; k < 2; ++k) dst[m][k] = *(const LAS bf16x8*)(lds + PG8_SA(b, h) + aoff + m * 2048 + k * 1024); } while (0)
#define PG8_LDB(dst, b, h) do { _Pragma("unroll") for (int n = 0; n < 2; ++n) _Pragma("unroll") for (int k = 0; k < 2; ++k) dst[n][k] = *(const LAS bf16x8*)(lds + PG8_SB(b, h) + boff + n * 2048 + k * 1024); } while (0)
#define PG8_MMA(ai, bj, At, Bt) do { __builtin_amdgcn_s_setprio(1); _Pragma("unroll") for (int m = 0; m < 4; ++m) _Pragma("unroll") for (int n = 0; n < 2; ++n) _Pragma("unroll") for (int k = 0; k < 2; ++k) \
        acc[ai][bj][m][n] = __builtin_amdgcn_mfma_f32_16x16x32_bf16(Bt[n][k], At[m][k], acc[ai][bj][m][n], 0, 0, 0); __builtin_amdgcn_s_setprio(0); } while (0)
#define PG8_WAIT_V(n) asm volatile("s_waitcnt vmcnt(" #n ")" ::: "memory")
#define PG8_WAIT_L(n) asm volatile("s_waitcnt lgkmcnt(" #n ")" ::: "memory")
#define PG8_BAR __builtin_amdgcn_s_barrier()
#define PG8_SCHED __builtin_amdgcn_sched_barrier(0)
    Unit cur, nxt; int ui = 0;
    if (!S.next(0, cur)) return;
    f32x4 acc[2][2][4][2];
#pragma unroll
    for (int a = 0; a < 2; ++a)
#pragma unroll
        for (int b = 0; b < 2; ++b)
#pragma unroll
            for (int m = 0; m < 4; ++m)
#pragma unroll
                for (int n = 0; n < 2; ++n) acc[a][b][m][n] = (f32x4){0.f, 0.f, 0.f, 0.f};
    bf16x8 At[4][2], B0[2][2], B1[2][2];
    const char* cA = (const char*)g.A + (size_t)cur.pm * tstep; const char* cB = (const char*)g.Bt + (size_t)cur.pn * tstep;
    PG8_STAGE(PG8_SB(0, 0), cB, voffB); PG8_STAGE(PG8_SB(0, 1), cB + hstep, voffB); PG8_STAGE(PG8_SA(0, 0), cA, voffA); PG8_STAGE(PG8_SA(0, 1), cA + hstep, voffA);
    if (wr == 1) PG8_BAR;
    PG8_WAIT_V(2); PG8_BAR;
    PG8_STAGE(PG8_SB(1, 0), cB + kstep, voffB); PG8_STAGE(PG8_SA(1, 0), cA + kstep, voffA); PG8_STAGE(PG8_SB(1, 1), cB + hstep + kstep, voffB);
    PG8_WAIT_V(6); PG8_BAR;
    for (;;) {
        const bool has_next = S.next(ui + 1, nxt);
        const char* nA = has_next ? (const char*)g.A + (size_t)nxt.pm * tstep : cA; const char* nB = has_next ? (const char*)g.Bt + (size_t)nxt.pn * tstep : cB;
        for (int t = 0; t < nt; t += 2) {
            const bool last = (t == nt - 2);
            const char* a1 = cA + (size_t)(t + 1) * kstep;
            const char* a2 = last ? nA : cA + (size_t)(t + 2) * kstep; const char* b2 = last ? nB : cB + (size_t)(t + 2) * kstep;
            const char* a3 = a2 + kstep; const char* b3 = b2 + kstep;
            PG8_LDB(B0, 0, 0); PG8_LDB(B1, 0, 1); PG8_SCHED; PG8_LDA(At, 0, 0); PG8_STAGE(PG8_SA(1, 1), a1 + hstep, voffA);
            PG8_WAIT_V(8); PG8_WAIT_L(0); PG8_BAR; PG8_MMA(0, 0, At, B0); PG8_MMA(0, 1, At, B1); PG8_BAR; PG8_SCHED;
            PG8_LDA(At, 0, 1); PG8_STAGE(PG8_SB(0, 0), b2, voffB); PG8_STAGE(PG8_SB(0, 1), b2 + hstep, voffB); PG8_STAGE(PG8_SA(0, 0), a2, voffA);
            PG8_WAIT_V(8); PG8_WAIT_L(0); PG8_BAR; PG8_MMA(1, 0, At, B0); PG8_MMA(1, 1, At, B1); PG8_BAR; PG8_SCHED;
            PG8_LDB(B0, 1, 0); PG8_LDB(B1, 1, 1); PG8_SCHED; PG8_LDA(At, 1, 0); PG8_STAGE(PG8_SA(0, 1), a2 + hstep, voffA);
            PG8_WAIT_V(8); PG8_WAIT_L(0); PG8_BAR; PG8_MMA(0, 0, At, B0); PG8_MMA(0, 1, At, B1); PG8_BAR; PG8_SCHED;
            PG8_LDA(At, 1, 1); PG8_STAGE(PG8_SB(1, 0), b3, voffB); PG8_STAGE(PG8_SB(1, 1), b3 + hstep, voffB); PG8_STAGE(PG8_SA(1, 0), a3, voffA);
            PG8_WAIT_V(8); PG8_WAIT_L(0); PG8_BAR; PG8_MMA(1, 0, At, B0); PG8_MMA(1, 1, At, B1); PG8_BAR; PG8_SCHED;
        }
        if constexpr (ALIGN_EPI) { if (wr == 0) PG8_BAR; }
        E(acc, cur, wr, wc, fr, fq);
        if (!has_next) break;
#pragma unroll
        for (int a = 0; a < 2; ++a)
#pragma unroll
            for (int b = 0; b < 2; ++b)
#pragma unroll
                for (int m = 0; m < 4; ++m)
#pragma unroll
                    for (int n = 0; n < 2; ++n) acc[a][b][m][n] = (f32x4){0.f, 0.f, 0.f, 0.f};
        cur = nxt; cA = nA; cB = nB; ++ui;
        if constexpr (ALIGN_EPI) { if (wr == 1) PG8_BAR; }
    }
    PG8_WAIT_V(0);
    if constexpr (!ALIGN_EPI) { if (wr == 0) PG8_BAR; }
    PG8_BAR;
#undef PG8_SA
#undef PG8_SB
#undef PG8_STAGE
#undef PG8_LDA
#undef PG8_LDB
#undef PG8_MMA
#undef PG8_WAIT_V
#undef PG8_WAIT_L
#undef PG8_BAR
#undef PG8_SCHED
}
}
using pg8::cvt_pk_bf16;

__device__ __forceinline__ float bf_lo(unsigned w) { return __uint_as_float(w << 16); }
__device__ __forceinline__ float bf_hi(unsigned w) { return __uint_as_float(w & 0xffff0000u); }
__device__ __forceinline__ float wave_sum(float v) {
#pragma unroll
    for (int o = 1; o < 64; o <<= 1) v += __shfl_xor(v, o);
    return v;
}
#define LDS_WAIT() asm volatile("s_waitcnt lgkmcnt(0)" ::: "memory")

struct Args { const float* in[23]; float* out; unsigned char* ws; int lo, hi; };

__device__ __forceinline__ void p0_transpose_item(const float* W, const float* gain, int K, int N, bf16_t* WT, LAS float* scr, int item, int lane) {
    const int nblk = N / 32, kb = item / nblk, nb = item % nblk, k0 = 64 * kb, n0 = 32 * nb;
#pragma unroll 8
    for (int i = 0; i < 32; ++i) { const int kk = 2 * i + (lane >> 5); const float gk = gain ? gain[k0 + kk] : 1.0f; scr[kk * 33 + (lane & 31)] = W[(size_t)(k0 + kk) * N + n0 + (lane & 31)] * gk; }
    LDS_WAIT(); asm volatile("" ::: "memory");
    const int c = lane & 7;
#pragma unroll
    for (int j = 0; j < 4; ++j) { const int n = (lane >> 3) + 8 * j; const LAS float* s = scr + (8 * c) * 33 + n;
        u32x4 o; o.x = cvt_pk_bf16(s[0 * 33], s[1 * 33]); o.y = cvt_pk_bf16(s[2 * 33], s[3 * 33]); o.z = cvt_pk_bf16(s[4 * 33], s[5 * 33]); o.w = cvt_pk_bf16(s[6 * 33], s[7 * 33]);
        *(u32x4*)(WT + (size_t)(n0 + n) * K + k0 + 8 * c) = o; }
    LDS_WAIT(); asm volatile("" ::: "memory");
}

template <bool PASS2>
__device__ __forceinline__ void a_unit(int u, int lane, const bf16_t* XR, const bf16_t* G, bf16_t* Y, float* AGG, const float* CARRY,
                                       const float* conv_w, const float* conv_b, const bf16_t* GW, const float* ga_b, const float* gx_b, const float* lam) {
    const int h = u & 15, cn = u >> 4, row0 = cn * 64;
    const bool first = (cn & 127) == 0;
    const int m = lane & 15, q = lane >> 4;
    const int tl = 16 * (m >> 2) + (m & 3);
    bf16x8 Af[4][3];
#pragma unroll
    for (int ks = 0; ks < 3; ++ks) {
        const int kc0 = 32 * ks + 8 * q; const bool kval = kc0 < HD;
        f32x4 w[4][2], bb[2];
#pragma unroll
        for (int k = 0; k < 4; ++k) { w[k][0] = (f32x4){0.f, 0.f, 0.f, 0.f}; w[k][1] = w[k][0]; }
        bb[0] = (f32x4){0.f, 0.f, 0.f, 0.f}; bb[1] = bb[0];
        if (kval) {
#pragma unroll
            for (int k = 0; k < 4; ++k) { const float* p = conv_w + k * DR + HD * h + kc0; w[k][0] = *(const f32x4*)p; w[k][1] = *(const f32x4*)(p + 4); }
            bb[0] = *(const f32x4*)(conv_b + HD * h + kc0); bb[1] = *(const f32x4*)(conv_b + HD * h + kc0 + 4);
        }
#pragma unroll
        for (int rt = 0; rt < 4; ++rt) {
            f32x4 a0 = bb[0], a1 = bb[1];
#pragma unroll
            for (int k = 0; k < 4; ++k) {
                const int t = tl + 4 * rt - 3 + k;
                u32x4 xv = (u32x4){0u, 0u, 0u, 0u};
                if (kval && !(first && t < 0)) xv = *(const u32x4*)(XR + (long)(row0 + t) * DR + HD * h + kc0);
                a0[0] += w[k][0][0] * bf_lo(xv.x); a0[1] += w[k][0][1] * bf_hi(xv.x); a0[2] += w[k][0][2] * bf_lo(xv.y); a0[3] += w[k][0][3] * bf_hi(xv.y);
                a1[0] += w[k][1][0] * bf_lo(xv.z); a1[1] += w[k][1][1] * bf_hi(xv.z); a1[2] += w[k][1][2] * bf_lo(xv.w); a1[3] += w[k][1][3] * bf_hi(xv.w);
            }
            u32x4 pk; pk.x = cvt_pk_bf16(a0[0], a0[1]); pk.y = cvt_pk_bf16(a0[2], a0[3]); pk.z = cvt_pk_bf16(a1[0], a1[1]); pk.w = cvt_pk_bf16(a1[2], a1[3]);
            Af[rt][ks] = __builtin_bit_cast(bf16x8, pk);
        }
    }
#pragma unroll 1
    for (int nt = 0; nt < 5; ++nt) {
        const int c = HD * h + 16 * nt + m;
        bf16x8 Ba[3], Bx[3];
#pragma unroll
        for (int ks = 0; ks < 3; ++ks) {
            Ba[ks] = *(const bf16x8*)(GW + ((size_t)((h * 2 + 0) * HD + 16 * nt + m)) * 96 + 32 * ks + 8 * q);
            Bx[ks] = *(const bf16x8*)(GW + ((size_t)((h * 2 + 1) * HD + 16 * nt + m)) * 96 + 32 * ks + 8 * q);
        }
        bf16x8 Iq;
#pragma unroll
        for (int j = 0; j < 8; ++j) Iq[j] = (8 * q + j == 16 * (nt & 1) + m) ? (short)0x3F80 : (short)0;
        f32x4 ar[4], ax[4], ac[4];
#pragma unroll
        for (int rt = 0; rt < 4; ++rt) {
            ar[rt] = (f32x4){0.f, 0.f, 0.f, 0.f}; ax[rt] = ar[rt]; ac[rt] = ar[rt];
#pragma unroll
            for (int ks = 0; ks < 3; ++ks) {
                ar[rt] = __builtin_amdgcn_mfma_f32_16x16x32_bf16(Af[rt][ks], Ba[ks], ar[rt], 0, 0, 0);
                ax[rt] = __builtin_amdgcn_mfma_f32_16x16x32_bf16(Af[rt][ks], Bx[ks], ax[rt], 0, 0, 0);
            }
            const bf16x8 Asel = (nt < 2) ? Af[rt][0] : ((nt < 4) ? Af[rt][1] : Af[rt][2]);
            ac[rt] = __builtin_amdgcn_mfma_f32_16x16x32_bf16(Asel, Iq, ac[rt], 0, 0, 0);
        }
        const float ba = ga_b[c], bx = gx_b[c];
        const float kc = -8.0f * log1pf(__expf(-lam[c])) * LOG2E;
        float hl = 0.f, ca = 1.f; float hs[16], cs[16];
#pragma unroll
        for (int rt = 0; rt < 4; ++rt)
#pragma unroll
            for (int i = 0; i < 4; ++i) {
                const float r = pg8::sigmoidf_(ar[rt][i] + ba), ig = pg8::sigmoidf_(ax[rt][i] + bx);
                const float a = pg8::fast_exp2(r * kc);
                const float mult = __builtin_amdgcn_sqrtf(fmaxf(1.0f - a * a, 0.f));
                const float uu = mult * ig * ac[rt][i];
                hl = a * hl + uu; ca *= a;
                if (PASS2) { hs[4 * rt + i] = hl; cs[4 * rt + i] = ca; }
            }
        const float A0 = __shfl(ca, m), H0 = __shfl(hl, m), A1 = __shfl(ca, m + 16), H1 = __shfl(hl, m + 16), A2 = __shfl(ca, m + 32), H2 = __shfl(hl, m + 32);
        if (!PASS2) {
            const float A3 = __shfl(ca, m + 48), H3 = __shfl(hl, m + 48);
            float s = H0; s = A1 * s + H1; s = A2 * s + H2; s = A3 * s + H3;
            const float P = (A0 * A1) * (A2 * A3);
            if (q == 0) *(f32x2*)(AGG + ((size_t)cn * DR + c) * 2) = (f32x2){P, s};
        } else {
            const float s0 = CARRY[(size_t)cn * DR + c];
            const float s1 = A0 * s0 + H0, s2 = A1 * s1 + H1, s3 = A2 * s2 + H2;
            const float sq = q == 0 ? s0 : (q == 1 ? s1 : (q == 2 ? s2 : s3));
#pragma unroll
            for (int st = 0; st < 16; ++st) {
                const size_t off = (size_t)(row0 + 16 * q + st) * DR + c;
                const float hv = hs[st] + cs[st] * sq;
                const float gv = __uint_as_float((unsigned)G[off] << 16);
                Y[off] = (bf16_t)(cvt_pk_bf16(hv * gv, 0.f) & 0xffffu);
            }
        }
    }
}

constexpr int LDV = 136;
__device__ __forceinline__ void sgu_unit(LAS unsigned char* lds, int u, int tid, int lane, int wave, const bf16_t* U, const bf16_t* V, bf16_t* Y,
                                         const float* ssv, const float* ng, const bf16_t* WSb, const float* sbias) {
    const int g = u & 7, cn = u >> 3, row0 = cn * 128;
    LAS bf16_t* vt = (LAS bf16_t*)lds;
    {
        const int c0 = 8 * (tid & 15);
        const f32x4 g0 = *(const f32x4*)(ng + g * 128 + c0), g1 = *(const f32x4*)(ng + g * 128 + c0 + 4);
#pragma unroll
        for (int i = 0; i < 2; ++i) {
            const int s = 2 * ((tid >> 4) + 32 * i);
            const u32x4 va = *(const u32x4*)(V + (size_t)(row0 + s) * D + g * 128 + c0), vb = *(const u32x4*)(V + (size_t)(row0 + s + 1) * D + g * 128 + c0);
            float sa = 0.f, sb = 0.f;
#pragma unroll
            for (int k = 0; k < 4; ++k) { const f32x4 pa = *(const f32x4*)(ssv + (size_t)(row0 + s) * 16 + 4 * k), pb = *(const f32x4*)(ssv + (size_t)(row0 + s + 1) * 16 + 4 * k);
                sa += (pa[0] + pa[1]) + (pa[2] + pa[3]); sb += (pb[0] + pb[1]) + (pb[2] + pb[3]); }
            const float ra = __builtin_amdgcn_rsqf(sa * (1.0f / 1024.0f) + EPS), rb = __builtin_amdgcn_rsqf(sb * (1.0f / 1024.0f) + EPS);
            LAS unsigned* dst = (LAS unsigned*)(vt + s);
            dst[(c0 + 0) * (LDV / 2)] = cvt_pk_bf16(bf_lo(va.x) * ra * g0[0], bf_lo(vb.x) * rb * g0[0]);
            dst[(c0 + 1) * (LDV / 2)] = cvt_pk_bf16(bf_hi(va.x) * ra * g0[1], bf_hi(vb.x) * rb * g0[1]);
            dst[(c0 + 2) * (LDV / 2)] = cvt_pk_bf16(bf_lo(va.y) * ra * g0[2], bf_lo(vb.y) * rb * g0[2]);
            dst[(c0 + 3) * (LDV / 2)] = cvt_pk_bf16(bf_hi(va.y) * ra * g0[3], bf_hi(vb.y) * rb * g0[3]);
            dst[(c0 + 4) * (LDV / 2)] = cvt_pk_bf16(bf_lo(va.z) * ra * g1[0], bf_lo(vb.z) * rb * g1[0]);
            dst[(c0 + 5) * (LDV / 2)] = cvt_pk_bf16(bf_hi(va.z) * ra * g1[1], bf_hi(vb.z) * rb * g1[1]);
            dst[(c0 + 6) * (LDV / 2)] = cvt_pk_bf16(bf_lo(va.w) * ra * g1[2], bf_lo(vb.w) * rb * g1[2]);
            dst[(c0 + 7) * (LDV / 2)] = cvt_pk_bf16(bf_hi(va.w) * ra * g1[3], bf_hi(vb.w) * rb * g1[3]);
        }
    }
    __syncthreads();
    {
        const int m = lane & 15, q = lane >> 4, t = 16 * wave + m, kmax = wave >> 1;
        bf16x8 Bw[4];
#pragma unroll
        for (int ks = 0; ks < 4; ++ks) { Bw[ks] = (bf16x8){0, 0, 0, 0, 0, 0, 0, 0}; if (ks <= kmax) Bw[ks] = *(const bf16x8*)(WSb + ((size_t)(g * 128 + t)) * 128 + 32 * ks + 8 * q); }
        const float bias = sbias[g * 128 + t];
#pragma unroll
        for (int p = 0; p < 4; ++p) {
            f32x4 ac[2];
#pragma unroll
            for (int e = 0; e < 2; ++e) {
                ac[e] = (f32x4){0.f, 0.f, 0.f, 0.f};
                const int cc = 32 * p + 8 * (m >> 2) + 4 * e + (m & 3);
#pragma unroll
                for (int ks = 0; ks < 4; ++ks) if (ks <= kmax) {
                    const bf16x8 Afr = *(const LAS bf16x8*)(vt + cc * LDV + 32 * ks + 8 * q);
                    ac[e] = __builtin_amdgcn_mfma_f32_16x16x32_bf16(Afr, Bw[ks], ac[e], 0, 0, 0);
                }
            }
            const size_t off = (size_t)(row0 + t) * D + g * 128 + 32 * p + 8 * q;
            const u32x4 uv = *(const u32x4*)(U + off);
            u32x4 o;
            o.x = cvt_pk_bf16(bf_lo(uv.x) * (ac[0][0] + bias), bf_hi(uv.x) * (ac[0][1] + bias));
            o.y = cvt_pk_bf16(bf_lo(uv.y) * (ac[0][2] + bias), bf_hi(uv.y) * (ac[0][3] + bias));
            o.z = cvt_pk_bf16(bf_lo(uv.z) * (ac[1][0] + bias), bf_hi(uv.z) * (ac[1][1] + bias));
            o.w = cvt_pk_bf16(bf_lo(uv.w) * (ac[1][2] + bias), bf_hi(uv.w) * (ac[1][3] + bias));
            *(u32x4*)(Y + off) = o;
        }
    }
    __syncthreads();
}


#define XB_TMO      128
#define XB_XCNT(j)  (256  + 64 * (j))
#define XB_XSUB(j)  (1280 + 64 * (j))
#define XB_XGEN(j)  (2304 + 64 * (j))
#define XB_TOP      3328
#define XB_TOPGEN   3392
#define XCD_BAR_WORDS 3456
#define XB_SPIN_CAP (1u << 18)
__device__ __forceinline__ unsigned xb_ld(unsigned* p)              { return __hip_atomic_load(p, __ATOMIC_RELAXED, __HIP_MEMORY_SCOPE_AGENT); }
__device__ __forceinline__ unsigned xb_add(unsigned* p, unsigned v) { return __hip_atomic_fetch_add(p, v, __ATOMIC_RELAXED, __HIP_MEMORY_SCOPE_AGENT); }
__device__ __forceinline__ unsigned xb_xcc_id() { return (unsigned)__builtin_amdgcn_s_getreg((3 << 11) | 20) & 0xFu; }
#define XB_SPIN(cond, bar) do { unsigned _sp = 0; while (cond) { __builtin_amdgcn_s_sleep(1); \
    if ((++_sp & 255u) == 0u) { if (xb_ld(&(bar)[XB_TMO])) break; if (_sp > XB_SPIN_CAP) { atomicAdd(&(bar)[XB_TMO], 1u); break; } } } } while (0)
struct XcdBarrier { unsigned* bar; unsigned x; volatile LAS unsigned* st; };
__device__ __forceinline__ XcdBarrier xcd_barrier_post(unsigned* bar, volatile LAS unsigned* st) {
    XcdBarrier b; b.bar = bar; b.x = xb_xcc_id(); b.st = st;
    if (threadIdx.x == 0) (void)xb_add(&bar[XB_XCNT(b.x)], 1u);
    return b;
}
__device__ __forceinline__ void xcd_barrier_complete(unsigned* bar, unsigned x, unsigned& nloc, unsigned& nx) {
    const unsigned G = gridDim.x * gridDim.y * gridDim.z;
    unsigned sum, cnt, mine, sp = 0u;
    for (;;) {
        sum = 0u; cnt = 0u; mine = 0u;
#pragma unroll
        for (unsigned j = 0; j < 16; ++j) { const unsigned c = xb_ld(&bar[XB_XCNT(j)]); sum += c; cnt += (c > 0u) ? 1u : 0u; mine = (j == x) ? c : mine; }
        if (sum == G) break;
        __builtin_amdgcn_s_sleep(1);
        if ((++sp & 255u) == 0u) { if (xb_ld(&bar[XB_TMO])) break; if (sp > XB_SPIN_CAP) { atomicAdd(&bar[XB_TMO], 1u); break; } }
    }
    nloc = mine > 0u ? mine : 1u; nx = cnt > 0u ? cnt : 1u;
}
__device__ __forceinline__ void xcd_barrier(const XcdBarrier& b) {
    asm volatile("s_waitcnt vmcnt(0)" ::: "memory");
    __syncthreads();
    if (threadIdx.x == 0) {
        unsigned* bar = b.bar;
        __builtin_amdgcn_s_waitcnt(0);
        unsigned nloc = b.st[0], nx = b.st[1];
        if (nloc == 0u) { xcd_barrier_complete(bar, b.x, nloc, nx); b.st[0] = nloc; b.st[1] = nx; }
        const unsigned old = xb_add(&bar[XB_XSUB(b.x)], 1u);
        const unsigned gen = old / nloc;
        if (old + 1u == (gen + 1u) * nloc) {
            __builtin_amdgcn_fence(__ATOMIC_RELEASE, "agent");
            asm volatile("s_waitcnt vmcnt(0)" ::: "memory");
            const unsigned og = xb_add(&bar[XB_TOP], 1u);
            const unsigned tg = og / nx;
            if (og + 1u == (tg + 1u) * nx) xb_add(&bar[XB_TOPGEN], 1u);
            else XB_SPIN(xb_ld(&bar[XB_TOPGEN]) == tg, bar);
            __builtin_amdgcn_fence(__ATOMIC_ACQUIRE, "agent");
            xb_add(&bar[XB_XGEN(b.x)], 1u);
            asm volatile("s_waitcnt vmcnt(0)" ::: "memory");
        } else {
            XB_SPIN(xb_ld(&bar[XB_XGEN(b.x)]) == gen, bar);
            __builtin_amdgcn_fence(__ATOMIC_ACQUIRE, "agent");
            asm volatile("s_waitcnt vmcnt(0)" ::: "memory");
        }
    }
    __syncthreads();
}

__global__ void __launch_bounds__(512, 2) trunk_fwd(Args args) {
    extern __shared__ __attribute__((aligned(16))) unsigned char lds_raw[];
    LAS unsigned char* lds = (LAS unsigned char*)lds_raw;
    const int G_ = gridDim.x, bx = blockIdx.x;
    const int NGW = G_ * 8, NGT = G_ * 512;
#define PHASE_IDS() int tid = threadIdx.x; asm volatile("" : "+v"(tid)); const int lane = tid & 63, wave = __builtin_amdgcn_readfirstlane(tid >> 6), gw = bx * 8 + wave, gtid = bx * 512 + tid; (void)lane; (void)wave; (void)gw; (void)gtid
    unsigned char* ws = args.ws;
    float* X = args.out;
    float* SSP = (float*)(ws + WS_SSP);
    bf16_t* XB = (bf16_t*)(ws + WS_XB);
    unsigned char* BIG = ws + WS_BIG;
    const int lo = args.lo, hi = args.hi;
    int ph = 0;
#define RUN() (ph >= lo && ph < hi)
    volatile LAS unsigned* bst = (volatile LAS unsigned*)(lds + 131072);
    if (threadIdx.x < 2) bst[threadIdx.x] = 0u;
    __syncthreads();
    XcdBarrier xbar; xbar.bar = (unsigned*)(ws + WS_BAR); xbar.x = 0; xbar.st = bst;
#define SEAM() do { ++ph; if (ph > lo && ph < hi) { if (ph == 1) { cg::this_grid().sync(); xbar = xcd_barrier_post((unsigned*)(ws + WS_BAR), bst); } else xcd_barrier(xbar); } } while (0)

    if (((PHMASK >> 0) & 1) && RUN()) { PHASE_IDS();
        if (bx == 0) for (int i = tid; i < XCD_BAR_WORDS; i += 512) ((unsigned*)(ws + WS_BAR))[i] = 0u;
        LAS float* scr = (LAS float*)(lds + wave * 16384);
#pragma unroll 1
        for (int mi = 0; mi < 16; ++mi) {
            const float* W; const float* gain = nullptr; bf16_t* WT; int K, N;
            if (mi < 2)        { W = args.in[4] + (size_t)mi * D * 2 * DR; gain = args.in[1] + (size_t)(3 * mi) * D; WT = (bf16_t*)(ws + W_AWIN) + (size_t)mi * D * 2 * DR; K = D; N = 2 * DR; }
            else if (mi < 4)   { const int j = mi - 2; W = args.in[12] + (size_t)j * DR * D; WT = (bf16_t*)(ws + W_AWOUT) + (size_t)j * DR * D; K = DR; N = D; }
            else if (mi == 4)  { W = args.in[13]; gain = args.in[1] + 1 * D; WT = (bf16_t*)(ws + W_BWIN); K = D; N = 2 * D; }
            else if (mi == 5)  { W = args.in[17]; WT = (bf16_t*)(ws + W_BWOUT); K = D; N = D; }
            else if (mi == 6)  { W = args.in[18]; gain = args.in[1] + 2 * D; WT = (bf16_t*)(ws + W_CWIN); K = D; N = 3 * D; }
            else if (mi == 7)  { W = args.in[20]; WT = (bf16_t*)(ws + W_CWOUT); K = D; N = D; }
            else if (mi < 12)  { const int i = mi - 8; W = args.in[21] + (size_t)i * D * FF; gain = args.in[2] + (size_t)i * D; WT = (bf16_t*)(ws + W_W1) + (size_t)i * D * FF; K = D; N = FF; }
            else               { const int i = mi - 12; W = args.in[22] + (size_t)i * FF * D; WT = (bf16_t*)(ws + W_W2) + (size_t)i * FF * D; K = FF; N = D; }
            const int nitems = (K / 64) * (N / 32);
#pragma unroll 1
            for (int it = gw; it < nitems; it += NGW) p0_transpose_item(W, gain, K, N, WT, scr, it, lane);
        }
        for (int id = gtid; id < 2 * NH * 2 * HD * 12; id += NGT) {
            const int k8 = id % 12, n = (id / 12) % HD, qq = (id / (12 * HD)) & 1, jh = id / (12 * HD * 2);
            const float* Wg = (qq ? args.in[9] : args.in[7]) + (size_t)jh * HD * HD;
            float v[8];
#pragma unroll
            for (int j = 0; j < 8; ++j) { const int k = 8 * k8 + j; v[j] = (k < HD) ? Wg[k * HD + n] : 0.f; }
            u32x4 o; o.x = cvt_pk_bf16(v[0], v[1]); o.y = cvt_pk_bf16(v[2], v[3]); o.z = cvt_pk_bf16(v[4], v[5]); o.w = cvt_pk_bf16(v[6], v[7]);
            *(u32x4*)((bf16_t*)(ws + WS_GW) + (size_t)id * 8) = o;
        }
        for (int id = gtid; id < 8 * 128 * 16; id += NGT) {
            const int s8 = id & 15, t = (id >> 4) & 127;
            const float* p = args.in[15] + (size_t)id * 8; float v[8];
#pragma unroll
            for (int j = 0; j < 8; ++j) v[j] = (8 * s8 + j <= t) ? p[j] : 0.f;
            u32x4 o; o.x = cvt_pk_bf16(v[0], v[1]); o.y = cvt_pk_bf16(v[2], v[3]); o.z = cvt_pk_bf16(v[4], v[5]); o.w = cvt_pk_bf16(v[6], v[7]);
            *(u32x4*)((bf16_t*)(ws + WS_WSB) + (size_t)id * 8) = o;
        }
        const float* x = args.in[0];
        for (int r = gw; r < M; r += NGW) {
            const f32x4* xr = (const f32x4*)(x + (size_t)r * D) + lane; float s = 0.f;
            unsigned long long* o8 = (unsigned long long*)(XB + (size_t)r * D) + lane;
#pragma unroll
            for (int j = 0; j < 4; ++j) { const f32x4 v = xr[64 * j]; s += (v[0] * v[0] + v[1] * v[1]) + (v[2] * v[2] + v[3] * v[3]);
                o8[64 * j] = (unsigned long long)cvt_pk_bf16(v[0], v[1]) | ((unsigned long long)cvt_pk_bf16(v[2], v[3]) << 32); }
            s = wave_sum(s);
            if (lane < 16) SSP[(size_t)r * 16 + lane] = (lane == 0) ? s : 0.f;
        }
    }
    SEAM();

#pragma unroll 1
    for (int L = 0; L < 4; ++L) {
        const int kind = L % 3, j = L / 3;
        const float* xbase = (L == 0) ? args.in[0] : X;
        const bf16_t* Ymix; const bf16_t* Wout; int Kout;
        if (kind == 0) {
            bf16_t* Gb = (bf16_t*)(BIG + A_G); bf16_t* XRb = (bf16_t*)(BIG + A_XR); bf16_t* Yb = (bf16_t*)(BIG + A_Y);
            float* AGG = (float*)(BIG + A_AGG); float* CARRY = (float*)(BIG + A_CARRY);
            if (((PHMASK >> 1) & 1) && RUN()) { PHASE_IDS();
                pg8::Gemm g{XB, (const bf16_t*)(ws + W_AWIN) + (size_t)j * D * 2 * DR, M, 2 * DR, D}; pg8::StaticOrder S; S.init(M, 2 * DR, G_, bx);
                pg8::EpiAct<0> E{Gb, DR, DR, (size_t)(A_XR - A_G) / 2, SSP, nullptr};
                pg8::gemm_phase<pg8::EpiAct<0>, pg8::StaticOrder>(lds, g, S, E);
            }
            SEAM();
            const float* cw = args.in[5] + (size_t)j * 4 * DR; const float* cb = args.in[6] + (size_t)j * DR;
            const bf16_t* GWl = (const bf16_t*)(ws + WS_GW) + (size_t)j * NH * 2 * HD * 96;
            const float* gab = args.in[8] + (size_t)j * DR; const float* gxb = args.in[10] + (size_t)j * DR; const float* lam = args.in[11] + (size_t)j * DR;
            if (((PHMASK >> 2) & 1) && RUN()) { PHASE_IDS();
#pragma unroll 1
                for (int u = gw; u < 256 * NH; u += NGW) a_unit<false>(u, lane, XRb, Gb, Yb, AGG, CARRY, cw, cb, GWl, gab, gxb, lam);
            }
            SEAM();
            if (((PHMASK >> 3) & 1) && RUN()) { PHASE_IDS();
                if (gtid < 2 * DR) {
                    const int b = gtid / DR, c = gtid % DR; float s = 0.f;
#pragma unroll 1
                    for (int n0 = 0; n0 < 128; n0 += 16) {
                        f32x2 pv[16];
#pragma unroll
                        for (int i = 0; i < 16; ++i) pv[i] = *(const f32x2*)(AGG + ((size_t)(b * 128 + n0 + i) * DR + c) * 2);
#pragma unroll
                        for (int i = 0; i < 16; ++i) { CARRY[(size_t)(b * 128 + n0 + i) * DR + c] = s; s = pv[i][0] * s + pv[i][1]; }
                    }
                }
            }
            SEAM();
            if (((PHMASK >> 4) & 1) && RUN()) { PHASE_IDS();
#pragma unroll 1
                for (int u = gw; u < 256 * NH; u += NGW) a_unit<true>(u, lane, XRb, Gb, Yb, AGG, CARRY, cw, cb, GWl, gab, gxb, lam);
            }
            SEAM();
            Ymix = Yb; Wout = (const bf16_t*)(ws + W_AWOUT) + (size_t)j * DR * D; Kout = DR;
        } else if (kind == 1) {
            bf16_t* Ub = (bf16_t*)(BIG + B_U); bf16_t* Vb = (bf16_t*)(BIG + B_V); bf16_t* Yb = (bf16_t*)(BIG + B_Y); float* SSV = (float*)(BIG + B_SSV);
            if (((PHMASK >> 5) & 1) && RUN()) { PHASE_IDS();
                pg8::Gemm g{XB, (const bf16_t*)(ws + W_BWIN), M, 2 * D, D}; pg8::StaticOrder S; S.init(M, 2 * D, G_, bx);
                pg8::EpiAct<2> E{Ub, D, D, (size_t)(B_V - B_U) / 2, SSP, SSV};
                pg8::gemm_phase<pg8::EpiAct<2>, pg8::StaticOrder>(lds, g, S, E);
            }
            SEAM();
            if (((PHMASK >> 6) & 1) && RUN()) { PHASE_IDS();
#pragma unroll 1
                for (int u = bx; u < 128 * 8; u += G_) sgu_unit(lds, u, tid, lane, wave, Ub, Vb, Yb, SSV, args.in[14], (const bf16_t*)(ws + WS_WSB), args.in[16]);
            }
            SEAM();
            Ymix = Yb; Wout = (const bf16_t*)(ws + W_BWOUT); Kout = D;
        } else {
            bf16_t* GCX = (bf16_t*)(BIG + C_GCX); bf16_t* Yb = (bf16_t*)(BIG + C_Y);
            if (((PHMASK >> 7) & 1) && RUN()) { PHASE_IDS();
                pg8::Gemm g{XB, (const bf16_t*)(ws + W_CWIN), M, 3 * D, D}; pg8::StaticOrder S; S.init(M, 3 * D, G_, bx);
                pg8::EpiAct<3> E{GCX, 3 * D, 0, 0, SSP, nullptr};
                pg8::gemm_phase<pg8::EpiAct<3>, pg8::StaticOrder>(lds, g, S, E);
            }
            SEAM();
            if (((PHMASK >> 8) & 1) && RUN()) { PHASE_IDS();
                const float* cw = args.in[19];
                for (int id = gtid; id < (M / 16) * 128; id += NGT) {
                    const int cgp = id & 127, r = id >> 7, c0 = 8 * cgp, rowb = r * 16;
                    f32x4 w[3][2];
#pragma unroll
                    for (int k = 0; k < 3; ++k) { w[k][0] = *(const f32x4*)(cw + k * D + c0); w[k][1] = *(const f32x4*)(cw + k * D + c0 + 4); }
                    float p2[8], p1[8];
#pragma unroll
                    for (int jj = 0; jj < 8; ++jj) { p2[jj] = 0.f; p1[jj] = 0.f; }
                    if ((rowb & (SEQ - 1)) != 0) {
                        const u32x4 ga = *(const u32x4*)(GCX + (size_t)(rowb - 2) * 3 * D + D + c0), xa = *(const u32x4*)(GCX + (size_t)(rowb - 2) * 3 * D + 2 * D + c0);
                        const u32x4 gb_ = *(const u32x4*)(GCX + (size_t)(rowb - 1) * 3 * D + D + c0), xb_ = *(const u32x4*)(GCX + (size_t)(rowb - 1) * 3 * D + 2 * D + c0);
                        p2[0] = bf_lo(ga.x) * bf_lo(xa.x); p2[1] = bf_hi(ga.x) * bf_hi(xa.x); p2[2] = bf_lo(ga.y) * bf_lo(xa.y); p2[3] = bf_hi(ga.y) * bf_hi(xa.y);
                        p2[4] = bf_lo(ga.z) * bf_lo(xa.z); p2[5] = bf_hi(ga.z) * bf_hi(xa.z); p2[6] = bf_lo(ga.w) * bf_lo(xa.w); p2[7] = bf_hi(ga.w) * bf_hi(xa.w);
                        p1[0] = bf_lo(gb_.x) * bf_lo(xb_.x); p1[1] = bf_hi(gb_.x) * bf_hi(xb_.x); p1[2] = bf_lo(gb_.y) * bf_lo(xb_.y); p1[3] = bf_hi(gb_.y) * bf_hi(xb_.y);
                        p1[4] = bf_lo(gb_.z) * bf_lo(xb_.z); p1[5] = bf_hi(gb_.z) * bf_hi(xb_.z); p1[6] = bf_lo(gb_.w) * bf_lo(xb_.w); p1[7] = bf_hi(gb_.w) * bf_hi(xb_.w);
                    }
#pragma unroll 4
                    for (int t = 0; t < 16; ++t) {
                        const size_t ro = (size_t)(rowb + t) * 3 * D + c0;
                        const u32x4 bb = *(const u32x4*)(GCX + ro), gc = *(const u32x4*)(GCX + ro + D), xv = *(const u32x4*)(GCX + ro + 2 * D);
                        float p0[8], gbv[8];
                        p0[0] = bf_lo(gc.x) * bf_lo(xv.x); p0[1] = bf_hi(gc.x) * bf_hi(xv.x); p0[2] = bf_lo(gc.y) * bf_lo(xv.y); p0[3] = bf_hi(gc.y) * bf_hi(xv.y);
                        p0[4] = bf_lo(gc.z) * bf_lo(xv.z); p0[5] = bf_hi(gc.z) * bf_hi(xv.z); p0[6] = bf_lo(gc.w) * bf_lo(xv.w); p0[7] = bf_hi(gc.w) * bf_hi(xv.w);
                        gbv[0] = bf_lo(bb.x); gbv[1] = bf_hi(bb.x); gbv[2] = bf_lo(bb.y); gbv[3] = bf_hi(bb.y); gbv[4] = bf_lo(bb.z); gbv[5] = bf_hi(bb.z); gbv[6] = bf_lo(bb.w); gbv[7] = bf_hi(bb.w);
                        float y[8];
#pragma unroll
                        for (int jj = 0; jj < 8; ++jj) { y[jj] = gbv[jj] * (w[0][jj >> 2][jj & 3] * p2[jj] + w[1][jj >> 2][jj & 3] * p1[jj] + w[2][jj >> 2][jj & 3] * p0[jj]); p2[jj] = p1[jj]; p1[jj] = p0[jj]; }
                        u32x4 o; o.x = cvt_pk_bf16(y[0], y[1]); o.y = cvt_pk_bf16(y[2], y[3]); o.z = cvt_pk_bf16(y[4], y[5]); o.w = cvt_pk_bf16(y[6], y[7]);
                        *(u32x4*)(Yb + (size_t)(rowb + t) * D + c0) = o;
                    }
                }
            }
            SEAM();
            Ymix = Yb; Wout = (const bf16_t*)(ws + W_CWOUT); Kout = D;
        }
        if (((PHMASK >> 9) & 1) && RUN()) { PHASE_IDS();
            pg8::Gemm g{Ymix, Wout, M, D, Kout}; pg8::StaticOrder S; S.init(M, D, G_, bx);
            pg8::EpiRes E{xbase, X, XB, SSP};
            pg8::gemm_phase<pg8::EpiRes, pg8::StaticOrder>(lds, g, S, E);
        }
        SEAM();
        if (((PHMASK >> 10) & 1) && RUN()) { PHASE_IDS();
            pg8::Gemm g{XB, (const bf16_t*)(ws + W_W1) + (size_t)L * D * FF, M, FF, D}; pg8::StaticOrder S; S.init(M, FF, G_, bx);
            pg8::EpiAct<1> E{(bf16_t*)BIG, FF, 0, 0, SSP, nullptr};
            pg8::gemm_phase<pg8::EpiAct<1>, pg8::StaticOrder>(lds, g, S, E);
        }
        SEAM();
        if (((PHMASK >> 11) & 1) && RUN()) { PHASE_IDS();
            pg8::Gemm g{(const bf16_t*)BIG, (const bf16_t*)(ws + W_W2) + (size_t)L * FF * D, M, D, FF}; pg8::StaticOrder S; S.init(M, D, G_, bx);
            pg8::EpiRes E{X, X, XB, SSP};
            pg8::gemm_phase<pg8::EpiRes, pg8::StaticOrder>(lds, g, S, E);
        }
        SEAM();
    }
    if (((PHMASK >> 12) & 1) && RUN()) { PHASE_IDS();
        const float* fg = args.in[3];
        for (int r = gw; r < M; r += NGW) {
            float s = (lane < 16) ? SSP[(size_t)r * 16 + lane] : 0.f;
            s = wave_sum(s);
            const float rs = __builtin_amdgcn_rsqf(s * (1.0f / 1024.0f) + EPS);
            f32x4* xr = (f32x4*)(X + (size_t)r * D) + lane; const f32x4* gr = (const f32x4*)fg + lane;
#pragma unroll
            for (int jj = 0; jj < 4; ++jj) { const f32x4 v = xr[64 * jj], gg = gr[64 * jj]; xr[64 * jj] = v * rs * gg; }
        }
    }
#undef RUN
#undef SEAM
}

extern "C" void kernel_launch(void* const* d_in, const int* in_sizes, int n_in, void* d_out, int out_size, void* d_ws, size_t ws_size, hipStream_t stream) {
    static int grid = 0;
    if (grid == 0) {
        if (n_in != 23 || in_sizes[0] != M * D || out_size != M * D || ws_size < WS_END) {
            fprintf(stderr, "kernel_launch: unexpected shapes (n_in %d, in0 %d, out %d, ws %zu < %zu); nothing launched\n", n_in, n_in > 0 ? in_sizes[0] : -1, out_size, ws_size, (size_t)WS_END); grid = -1; return; }
        int dev = 0, cus = 0, per_cu = 0;
        if (hipGetDevice(&dev) != hipSuccess || hipDeviceGetAttribute(&cus, hipDeviceAttributeMultiprocessorCount, dev) != hipSuccess) { grid = -1; return; }
        if (hipFuncSetAttribute((const void*)trunk_fwd, hipFuncAttributeMaxDynamicSharedMemorySize, LDS_BYTES) != hipSuccess) { fprintf(stderr, "kernel_launch: hipFuncSetAttribute failed\n"); grid = -1; return; }
        if (hipOccupancyMaxActiveBlocksPerMultiprocessor(&per_cu, (const void*)trunk_fwd, 512, LDS_BYTES) != hipSuccess || per_cu < 1) { fprintf(stderr, "kernel_launch: occupancy query gave %d\n", per_cu); per_cu = 1; }
        (void)hipGetLastError();
        grid = cus * per_cu;
    }
    if (grid < 0) return;
    Args a{};
    for (int i = 0; i < 23; ++i) a.in[i] = (const float*)d_in[i];
    a.out = (float*)d_out; a.ws = (unsigned char*)d_ws;
#if MK_MULTI
    for (int p = 0; p < NPHASE; ++p) { a.lo = p; a.hi = p + 1; hipLaunchKernelGGL(trunk_fwd, dim3(grid), dim3(512), LDS_BYTES, stream, a); }
#else
    a.lo = 0; a.hi = NPHASE;
    void* kargs[] = {(void*)&a};
    hipError_t e = hipLaunchCooperativeKernel((const void*)trunk_fwd, dim3(grid), dim3(512), kargs, LDS_BYTES, stream);
    if (e != hipSuccess) fprintf(stderr, "kernel_launch: cooperative launch failed: %s (grid %d)\n", hipGetErrorString(e), grid);
#endif
}
```

```cpp
#include <hip/hip_runtime.h>
#include <hip/hip_cooperative_groups.h>
#include <cstdio>
#include <cstdint>
namespace cg = cooperative_groups;

#ifndef PHMASK
#define PHMASK 0xFFFFFFFFu
#endif
#ifndef REP_0
#define REP_0 1
#endif
#ifndef REP_1
#define REP_1 1
#endif
#ifndef REP_2
#define REP_2 1
#endif
#ifndef REP_3
#define REP_3 1
#endif
#ifndef REP_4
#define REP_4 1
#endif
#ifndef REP_5
#define REP_5 1
#endif
#ifndef REP_6
#define REP_6 1
#endif
#ifndef REP_7
#define REP_7 1
#endif
#ifndef REP_8
#define REP_8 1
#endif
#ifndef REP_9
#define REP_9 1
#endif
#ifndef REP_10
#define REP_10 1
#endif
#ifndef REP_11
#define REP_11 1
#endif
#ifndef REP_12
#define REP_12 1
#endif
#ifndef MK_MULTI
#define MK_MULTI 0
#endif

#define LAS __attribute__((address_space(3)))
typedef unsigned short bf16_t;
typedef short bf16x8 __attribute__((ext_vector_type(8)));
typedef float f32x4 __attribute__((ext_vector_type(4)));
typedef float f32x2 __attribute__((ext_vector_type(2)));
typedef unsigned u32x4 __attribute__((ext_vector_type(4)));
typedef unsigned u32x2 __attribute__((ext_vector_type(2)));

constexpr int SEQ = 8192, M = 2 * SEQ, D = 1024, DR = 1280, FF = 4096, NH = 16, HD = 80;
constexpr float EPS = 1e-6f, LOG2E = 1.4426950408889634f;
constexpr int NPHASE = 26;

constexpr size_t MiB = 1u << 20;
constexpr size_t WS_SSP = 0;
constexpr size_t WS_GW = 1 * MiB;
constexpr size_t WS_BAR = 1 * MiB + 983040;
constexpr size_t WS_WSB = 2 * MiB;
constexpr size_t WS_W = 2 * MiB + 256 * 1024;
constexpr size_t W_AWIN = WS_W, W_AWOUT = WS_W + 10 * MiB, W_BWIN = WS_W + 15 * MiB, W_BWOUT = WS_W + 19 * MiB, W_CWIN = WS_W + 21 * MiB,
                 W_CWOUT = WS_W + 27 * MiB, W_W1 = WS_W + 29 * MiB, W_W2 = WS_W + 61 * MiB;
constexpr size_t WS_XB = WS_W + 93 * MiB;
constexpr size_t WS_BIG = WS_XB + 32 * MiB;
constexpr size_t WS_END = WS_BIG + 128 * MiB;
constexpr size_t A_G = 0, A_XR = 40 * MiB, A_Y = 80 * MiB, A_AGG = 120 * MiB, A_CARRY = 124 * MiB;
constexpr size_t B_U = 0, B_V = 32 * MiB, B_Y = 64 * MiB, B_SSV = 96 * MiB;
constexpr size_t C_GCX = 0, C_Y = 96 * MiB;

constexpr int LDS_BYTES = 147456;

namespace pg8 {
constexpr int BM = 256, BK = 64, HALF = 128, HTB = HALF * BK * 2, STAGE_BYTES = 8 * HTB, NXCD = 8, WGM = 8;
__host__ __device__ __forceinline__ int lds_byte(int r, int c) { const int st = (r >> 4) * 2 + (c >> 5), rr = r & 15, cc = c & 31, ob = rr * 64 + cc * 2; return st * 1024 + (ob ^ (((ob >> 9) & 1) << 5)); }
__host__ __device__ __forceinline__ void stage_rc(int b, int& R, int& C) { const int st = b / 1024, sb = b % 1024, swz = sb ^ (((sb >> 9) & 1) << 5); R = (st >> 1) * 16 + swz / 64; C = (st & 1) * 32 + (swz % 64) / 2; }
__host__ __device__ __forceinline__ int perm32(int rho) { const int n = rho >> 4, i = rho & 15; return 8 * (i >> 2) + 4 * n + (i & 3); }

struct Unit { int pm, pn; };
struct Gemm { const bf16_t* A; const bf16_t* Bt; int M, N, K; };

struct StaticOrder {
    int nM, nN, nwg, G, c;
    __host__ __device__ void init(int M_, int N_, int G_, int c_) { nM = M_ / BM; nN = N_ / BM; nwg = nM * nN; G = G_; c = c_; }
    __host__ __device__ bool next(int i, Unit& u) const {
        const long L = (long)i * G + c; if (L >= nwg) return false;
        int wgid = (int)L; { const int q = nwg / NXCD, r = nwg % NXCD, xcd = wgid % NXCD, off = wgid / NXCD; wgid = (xcd < r ? xcd * (q + 1) : r * (q + 1) + (xcd - r) * q) + off; }
        const int nig = WGM * nN, gid = wgid / nig, fm = gid * WGM, gsz = (nM - fm) < WGM ? (nM - fm) : WGM;
        u.pm = fm + ((wgid % nig) % gsz); u.pn = (wgid % nig) / gsz; return true;
    }
};

__device__ __forceinline__ unsigned cvt_pk_bf16(float lo, float hi) { unsigned r; asm volatile("v_cvt_pk_bf16_f32 %0, %1, %2" : "=v"(r) : "v"(lo), "v"(hi)); return r; }
__device__ __forceinline__ float fast_rcp(float x) { return __builtin_amdgcn_rcpf(x); }
__device__ __forceinline__ float fast_exp2(float x) { return __builtin_amdgcn_exp2f(x); }
__device__ __forceinline__ float sigmoidf_(float z) { return fast_rcp(1.0f + fast_exp2(-LOG2E * z)); }
__device__ __forceinline__ float gelu_tanh(float x) { const float z = x * (1.0f + 0.044715f * x * x); return x * fast_rcp(1.0f + fast_exp2(-2.0f * 0.7978845608028654f * LOG2E * z)); }

__device__ __forceinline__ float row_rs(const float* ssp, int row, int fq) {
    const f32x4 p = *(const f32x4*)(ssp + (size_t)row * 16 + 4 * fq);
    float s = (p[0] + p[1]) + (p[2] + p[3]);
    s += __shfl_xor(s, 16); s += __shfl_xor(s, 32);
    return __builtin_amdgcn_rsqf(s * (1.0f / 1024.0f) + EPS);
}

template <int MODE> struct EpiAct {
    static constexpr bool PERM = true, AFTER_DRAIN = false;
    bf16_t* O; int ldc; int split_cols; size_t split_stride; const float* ssp; float* ssv;
    __device__ __forceinline__ void operator()(const f32x4 (&acc)[2][2][4][2], const Unit& u, int wr, int wc, int fr, int fq) const {
        const int row0 = u.pm * BM + wr * 64 + fr; int colt = u.pn * BM; bf16_t* base = O; int t = 0;
        if (split_cols) { t = colt / split_cols; base += (size_t)t * split_stride; colt -= t * split_cols; }
        const int col0 = colt + wc * 32 + 8 * fq;
#pragma unroll
        for (int ai = 0; ai < 2; ++ai)
#pragma unroll
            for (int m = 0; m < 4; ++m) {
                const int row = row0 + ai * HALF + m * 16;
                const float rs = row_rs(ssp, row, fq);
                bf16_t* rowp = base + (size_t)row * ldc + col0; float vs = 0.f;
#pragma unroll
                for (int bj = 0; bj < 2; ++bj) {
                    f32x4 v0 = acc[ai][bj][m][0] * rs, v1 = acc[ai][bj][m][1] * rs;
                    if (MODE == 0) { if (t == 0) {
#pragma unroll
                        for (int j = 0; j < 4; ++j) { v0[j] = gelu_tanh(v0[j]); v1[j] = gelu_tanh(v1[j]); } } }
                    if (MODE == 1) {
#pragma unroll
                        for (int j = 0; j < 4; ++j) { const float a = fmaxf(v0[j], 0.f), b = fmaxf(v1[j], 0.f); v0[j] = a * a; v1[j] = b * b; } }
                    if (MODE == 2) {
#pragma unroll
                        for (int j = 0; j < 4; ++j) { v0[j] = gelu_tanh(v0[j]); v1[j] = gelu_tanh(v1[j]); }
                        vs += (v0[0] * v0[0] + v0[1] * v0[1]) + (v0[2] * v0[2] + v0[3] * v0[3]) + (v1[0] * v1[0] + v1[1] * v1[1]) + (v1[2] * v1[2] + v1[3] * v1[3]); }
                    u32x4 w; w.x = cvt_pk_bf16(v0[0], v0[1]); w.y = cvt_pk_bf16(v0[2], v0[3]); w.z = cvt_pk_bf16(v1[0], v1[1]); w.w = cvt_pk_bf16(v1[2], v1[3]);
                    *(u32x4*)(rowp + bj * HALF) = w;
                }
                if (MODE == 2) { vs += __shfl_xor(vs, 16); vs += __shfl_xor(vs, 32);
                    if (t == 1 && fq == 0) ssv[(size_t)row * 16 + (u.pn - 4) * 4 + wc] = vs; }
            }
    }
};
struct EpiRes {
    static constexpr bool PERM = true, AFTER_DRAIN = false;
    const float* base; float* out; bf16_t* xb; float* ssp;
    __device__ __forceinline__ void operator()(const f32x4 (&acc)[2][2][4][2], const Unit& u, int wr, int wc, int fr, int fq) const {
        const int row0 = u.pm * BM + wr * 64 + fr, col0 = u.pn * BM + wc * 32 + 8 * fq;
#pragma unroll
        for (int ai = 0; ai < 2; ++ai)
#pragma unroll
            for (int m = 0; m < 4; ++m) {
                const int row = row0 + ai * HALF + m * 16; float ss = 0.f;
#pragma unroll
                for (int bj = 0; bj < 2; ++bj) {
                    const size_t off = (size_t)row * D + col0 + bj * HALF;
                    const f32x4 b0 = *(const f32x4*)(base + off), b1 = *(const f32x4*)(base + off + 4);
                    const f32x4 v0 = acc[ai][bj][m][0] + b0, v1 = acc[ai][bj][m][1] + b1;
                    *(f32x4*)(out + off) = v0; *(f32x4*)(out + off + 4) = v1;
                    ss += (v0[0] * v0[0] + v0[1] * v0[1]) + (v0[2] * v0[2] + v0[3] * v0[3]) + (v1[0] * v1[0] + v1[1] * v1[1]) + (v1[2] * v1[2] + v1[3] * v1[3]);
                    u32x4 w; w.x = cvt_pk_bf16(v0[0], v0[1]); w.y = cvt_pk_bf16(v0[2], v0[3]); w.z = cvt_pk_bf16(v1[0], v1[1]); w.w = cvt_pk_bf16(v1[2], v1[3]);
                    *(u32x4*)(xb + off) = w;
                }
                ss += __shfl_xor(ss, 16); ss += __shfl_xor(ss, 32);
                if (fq == 0) ssp[(size_t)row * 16 + u.pn * 4 + wc] = ss;
            }
    }
};

template <class Epi, class Sched, bool ALIGN_EPI = true>
__device__ __forceinline__ void gemm_phase(LAS unsigned char* lds, const Gemm g, const Sched& S, const Epi& E) {
    int tid_o = threadIdx.x; asm volatile("" : "+v"(tid_o));
    const int tid = tid_o, wid = __builtin_amdgcn_readfirstlane(tid >> 6), lane = tid & 63, wr = wid >> 2, wc = wid & 3, fr = lane & 15, fq = lane >> 4;
    const int K = g.K, nt = K / BK;
    unsigned voffA[2], voffB[2];
#pragma unroll
    for (int i = 0; i < 2; ++i) { int R, C; stage_rc(tid * 16 + i * 8192, R, C); const int Rb = Epi::PERM ? ((R & ~31) + perm32(R & 31)) : R;
        voffA[i] = (unsigned)(R * K + C) * 2u; voffB[i] = (unsigned)(Rb * K + C) * 2u; }
    const size_t kstep = (size_t)(BK * 2);
    const size_t hstep = (size_t)HALF * K * 2;
    const size_t tstep = 2 * hstep;
    const unsigned ldsw = (unsigned)wid * 1024u;
    const int aoff = lds_byte(wr * 64 + fr, fq * 8), boff = lds_byte(wc * 32 + fr, fq * 8);
#define PG8_SA(b, h) (((b) * 2 + (h)) * HTB)
#define PG8_SB(b, h) ((4 + (b) * 2 + (h)) * HTB)
#define PG8_STAGE(bufoff, gbase, voff) do { _Pragma("unroll") for (int _i = 0; _i < 2; ++_i) \
        __builtin_amdgcn_global_load_lds((const unsigned*)((const char*)(gbase) + (voff)[_i]), (LAS unsigned*)(lds + (bufoff) + ldsw + _i * 8192), 16, 0, 0); } while (0)
#define PG8_LDA(dst, b, h) do { _Pragma("unroll") for (int m = 0; m < 4; ++m) _Pragma("unroll") for (int k = 0; k < 2; ++k) dst[m][k] = *(const LAS bf16x8*)(lds + PG8_SA(b, h) + aoff + m * 2048 + k * 1024); } while (0)
#define PG8_LDB(dst, b, h) do { _Pragma("unroll") for (int n = 0; n < 2; ++n) _Pragma("unroll") for (int k = 0; k < 2; ++k) dst[n][k] = *(const LAS bf16x8*)(lds + PG8_SB(b, h) + boff + n * 2048 + k * 1024); } while (0)
#define PG8_MMA(ai, bj, At, Bt) do { __builtin_amdgcn_s_setprio(1); _Pragma("unroll") for (int m = 0; m < 4; ++m) _Pragma("unroll") for (int n = 0; n < 2; ++n) _Pragma("unroll") for (int k = 0; k < 2; ++k) \
        acc[ai][bj][m][n] = __builtin_amdgcn_mfma_f32_16x16x32_bf16(Bt[n][k], At[m][k], acc[ai][bj][m][n], 0, 0, 0); __builtin_amdgcn_s_setprio(0); } while (0)
#define PG8_WAIT_V(n) asm volatile("s_waitcnt vmcnt(" #n ")" ::: "memory")
#define PG8_WAIT_L(n) asm volatile("s_waitcnt lgkmcnt(" #n ")" ::: "memory")
#define PG8_BAR __builtin_amdgcn_s_barrier()
#define PG8_SCHED __builtin_amdgcn_sched_barrier(0)
    Unit cur, nxt; int ui = 0;
    if (!S.next(0, cur)) return;
    f32x4 acc[2][2][4][2];
#pragma unroll
    for (int a = 0; a < 2; ++a)
#pragma unroll
        for (int b = 0; b < 2; ++b)
#pragma unroll
            for (int m = 0; m < 4; ++m)
#pragma unroll
                for (int n = 0; n < 2; ++n) acc[a][b][m][n] = (f32x4){0.f, 0.f, 0.f, 0.f};
    bf16x8 At[4][2], B0[2][2], B1[2][2];
    const char* cA = (const char*)g.A + (size_t)cur.pm * tstep; const char* cB = (const char*)g.Bt + (size_t)cur.pn * tstep;
    PG8_STAGE(PG8_SB(0, 0), cB, voffB); PG8_STAGE(PG8_SB(0, 1), cB + hstep, voffB); PG8_STAGE(PG8_SA(0, 0), cA, voffA); PG8_STAGE(PG8_SA(0, 1), cA + hstep, voffA);
    if (wr == 1) PG8_BAR;
    PG8_WAIT_V(2); PG8_BAR;
    PG8_STAGE(PG8_SB(1, 0), cB + kstep, voffB); PG8_STAGE(PG8_SA(1, 0), cA + kstep, voffA); PG8_STAGE(PG8_SB(1, 1), cB + hstep + kstep, voffB);
    PG8_WAIT_V(6); PG8_BAR;
    for (;;) {
        const bool has_next = S.next(ui + 1, nxt);
        const char* nA = has_next ? (const char*)g.A + (size_t)nxt.pm * tstep : cA; const char* nB = has_next ? (const char*)g.Bt + (size_t)nxt.pn * tstep : cB;
        for (int t = 0; t < nt; t += 2) {
            const bool last = (t == nt - 2);
            const char* a1 = cA + (size_t)(t + 1) * kstep;
            const char* a2 = last ? nA : cA + (size_t)(t + 2) * kstep; const char* b2 = last ? nB : cB + (size_t)(t + 2) * kstep;
            const char* a3 = a2 + kstep; const char* b3 = b2 + kstep;
            PG8_LDB(B0, 0, 0); PG8_LDB(B1, 0, 1); PG8_SCHED; PG8_LDA(At, 0, 0); PG8_STAGE(PG8_SA(1, 1), a1 + hstep, voffA);
            PG8_WAIT_V(8); PG8_WAIT_L(0); PG8_BAR; PG8_MMA(0, 0, At, B0); PG8_MMA(0, 1, At, B1); PG8_BAR; PG8_SCHED;
            PG8_LDA(At, 0, 1); PG8_STAGE(PG8_SB(0, 0), b2, voffB); PG8_STAGE(PG8_SB(0, 1), b2 + hstep, voffB); PG8_STAGE(PG8_SA(0, 0), a2, voffA);
            PG8_WAIT_V(8); PG8_WAIT_L(0); PG8_BAR; PG8_MMA(1, 0, At, B0); PG8_MMA(1, 1, At, B1); PG8_BAR; PG8_SCHED;
            PG8_LDB(B0, 1, 0); PG8_LDB(B1, 1, 1); PG8_SCHED; PG8_LDA(At, 1, 0); PG8_STAGE(PG8_SA(0, 1), a2 + hstep, voffA);
            PG8_WAIT_V(8); PG8_WAIT_L(0); PG8_BAR; PG8_MMA(0, 0, At, B0); PG8_MMA(0, 1, At, B1); PG8_BAR; PG8_SCHED;
            PG8_LDA(At, 1, 1); PG8_STAGE(PG8_SB(1, 0), b3, voffB); PG8_STAGE(PG8_SB(1, 1), b3 + hstep, voffB); PG8_STAGE(PG8_SA(1, 0), a3, voffA);
            PG8_WAIT_V(8); PG8_WAIT_L(0); PG8_BAR; PG8_MMA(1, 0, At, B0); PG8_MMA(1, 1, At, B1); PG8_BAR; PG8_SCHED;
        }
        if constexpr (ALIGN_EPI) { if (wr == 0) PG8_BAR; }
        E(acc, cur, wr, wc, fr, fq);
        if (!has_next) break;
#pragma unroll
        for (int a = 0; a < 2; ++a)
#pragma unroll
            for (int b = 0; b < 2; ++b)
#pragma unroll
                for (int m = 0; m < 4; ++m)
#pragma unroll
                    for (int n = 0; n < 2; ++n) acc[a][b][m][n] = (f32x4){0.f, 0.f, 0.f, 0.f};
        cur = nxt; cA = nA; cB = nB; ++ui;
        if constexpr (ALIGN_EPI) { if (wr == 1) PG8_BAR; }
    }
    PG8_WAIT_V(0);
    if constexpr (!ALIGN_EPI) { if (wr == 0) PG8_BAR; }
    PG8_BAR;
#undef PG8_SA
#undef PG8_SB
#undef PG8_STAGE
#undef PG8_LDA
#undef PG8_LDB
#undef PG8_MMA
#undef PG8_WAIT_V
#undef PG8_WAIT_L
#undef PG8_BAR
#undef PG8_SCHED
}
}
using pg8::cvt_pk_bf16;

__device__ __forceinline__ float bf_lo(unsigned w) { return __uint_as_float(w << 16); }
__device__ __forceinline__ float bf_hi(unsigned w) { return __uint_as_float(w & 0xffff0000u); }
__device__ __forceinline__ float wave_sum(float v) {
#pragma unroll
    for (int o = 1; o < 64; o <<= 1) v += __shfl_xor(v, o);
    return v;
}
#define LDS_WAIT() asm volatile("s_waitcnt lgkmcnt(0)" ::: "memory")

struct Args { const float* in[23]; float* out; unsigned char* ws; int lo, hi; };

struct P0Item { const float* W; const float* gain; bf16_t* WT; int K, N, k0, n0; };
__device__ __forceinline__ P0Item p0_decode(const Args& a, unsigned char* ws, int it) {
    P0Item d; d.gain = nullptr; int r = it;
    if (r < 2560)        { const int j = r / 1280; r -= j * 1280; d.W = a.in[4] + (size_t)j * D * 2 * DR; d.gain = a.in[1] + (size_t)(3 * j) * D; d.WT = (bf16_t*)(ws + W_AWIN) + (size_t)j * D * 2 * DR; d.K = D; d.N = 2 * DR; }
    else if (r < 3840)   { r -= 2560; const int j = r / 640; r -= j * 640; d.W = a.in[12] + (size_t)j * DR * D; d.WT = (bf16_t*)(ws + W_AWOUT) + (size_t)j * DR * D; d.K = DR; d.N = D; }
    else if (r < 4864)   { r -= 3840; d.W = a.in[13]; d.gain = a.in[1] + 1 * D; d.WT = (bf16_t*)(ws + W_BWIN); d.K = D; d.N = 2 * D; }
    else if (r < 5376)   { r -= 4864; d.W = a.in[17]; d.WT = (bf16_t*)(ws + W_BWOUT); d.K = D; d.N = D; }
    else if (r < 6912)   { r -= 5376; d.W = a.in[18]; d.gain = a.in[1] + 2 * D; d.WT = (bf16_t*)(ws + W_CWIN); d.K = D; d.N = 3 * D; }
    else if (r < 7424)   { r -= 6912; d.W = a.in[20]; d.WT = (bf16_t*)(ws + W_CWOUT); d.K = D; d.N = D; }
    else if (r < 15616)  { r -= 7424; const int i = r >> 11; r &= 2047; d.W = a.in[21] + (size_t)i * D * FF; d.gain = a.in[2] + (size_t)i * D; d.WT = (bf16_t*)(ws + W_W1) + (size_t)i * D * FF; d.K = D; d.N = FF; }
    else                 { r -= 15616; const int i = r >> 11; r &= 2047; d.W = a.in[22] + (size_t)i * FF * D; d.WT = (bf16_t*)(ws + W_W2) + (size_t)i * FF * D; d.K = FF; d.N = D; }
    const int nblk = d.N / 32; d.k0 = 64 * (r / nblk); d.n0 = 32 * (r % nblk);
    return d;
}
constexpr int P0_NITEMS = 23808;
__device__ __forceinline__ void p0_load(const P0Item& d, int lane, f32x4 (&R)[8]) {
    const float* p = d.W + (size_t)(d.k0 + (lane >> 3)) * d.N + d.n0 + 4 * (lane & 7);
#pragma unroll
    for (int i = 0; i < 8; ++i) R[i] = __builtin_nontemporal_load((const f32x4*)(p + (size_t)(8 * i) * d.N));
}
__device__ __forceinline__ void p0_store(const P0Item& d, int lane, const f32x4 (&R)[8], LAS float* scr) {
#pragma unroll
    for (int i = 0; i < 8; ++i) { const int kk = 8 * i + (lane >> 3); const float gk = d.gain ? d.gain[d.k0 + kk] : 1.0f; LAS float* s = scr + kk * 33 + 4 * (lane & 7);
        s[0] = R[i][0] * gk; s[1] = R[i][1] * gk; s[2] = R[i][2] * gk; s[3] = R[i][3] * gk; }
    LDS_WAIT(); asm volatile("" ::: "memory");
    const int c = lane & 7;
#pragma unroll
    for (int j = 0; j < 4; ++j) { const int n = (lane >> 3) + 8 * j; const LAS float* s = scr + (8 * c) * 33 + n;
        u32x4 o; o.x = cvt_pk_bf16(s[0 * 33], s[1 * 33]); o.y = cvt_pk_bf16(s[2 * 33], s[3 * 33]); o.z = cvt_pk_bf16(s[4 * 33], s[5 * 33]); o.w = cvt_pk_bf16(s[6 * 33], s[7 * 33]);
        *(u32x4*)(d.WT + (size_t)(d.n0 + n) * d.K + d.k0 + 8 * c) = o; }
    LDS_WAIT(); asm volatile("" ::: "memory");
}

template <bool PASS2>
__device__ __forceinline__ void a_unit(int u, int lane, const bf16_t* XR, const bf16_t* G, bf16_t* Y, float* AGG, const float* CARRY,
                                       const float* conv_w, const float* conv_b, const bf16_t* GW, const float* ga_b, const float* gx_b, const float* lam) {
    const int h = u & 15, cn = u >> 4, row0 = cn * 64;
    const bool first = (cn & 127) == 0;
    const int m = lane & 15, q = lane >> 4;
    const int tl = 16 * (m >> 2) + (m & 3);
    bf16x8 Af[4][3];
#pragma unroll
    for (int ks = 0; ks < 3; ++ks) {
        const int kc0 = 32 * ks + 8 * q; const bool kval = kc0 < HD;
        f32x4 w[4][2], bb[2];
#pragma unroll
        for (int k = 0; k < 4; ++k) { w[k][0] = (f32x4){0.f, 0.f, 0.f, 0.f}; w[k][1] = w[k][0]; }
        bb[0] = (f32x4){0.f, 0.f, 0.f, 0.f}; bb[1] = bb[0];
        if (kval) {
#pragma unroll
            for (int k = 0; k < 4; ++k) { const float* p = conv_w + k * DR + HD * h + kc0; w[k][0] = *(const f32x4*)p; w[k][1] = *(const f32x4*)(p + 4); }
            bb[0] = *(const f32x4*)(conv_b + HD * h + kc0); bb[1] = *(const f32x4*)(conv_b + HD * h + kc0 + 4);
        }
#pragma unroll
        for (int rt = 0; rt < 4; ++rt) {
            f32x4 a0 = bb[0], a1 = bb[1];
#pragma unroll
            for (int k = 0; k < 4; ++k) {
                const int t = tl + 4 * rt - 3 + k;
                u32x4 xv = (u32x4){0u, 0u, 0u, 0u};
                if (kval && !(first && t < 0)) xv = *(const u32x4*)(XR + (long)(row0 + t) * DR + HD * h + kc0);
                a0[0] += w[k][0][0] * bf_lo(xv.x); a0[1] += w[k][0][1] * bf_hi(xv.x); a0[2] += w[k][0][2] * bf_lo(xv.y); a0[3] += w[k][0][3] * bf_hi(xv.y);
                a1[0] += w[k][1][0] * bf_lo(xv.z); a1[1] += w[k][1][1] * bf_hi(xv.z); a1[2] += w[k][1][2] * bf_lo(xv.w); a1[3] += w[k][1][3] * bf_hi(xv.w);
            }
            u32x4 pk; pk.x = cvt_pk_bf16(a0[0], a0[1]); pk.y = cvt_pk_bf16(a0[2], a0[3]); pk.z = cvt_pk_bf16(a1[0], a1[1]); pk.w = cvt_pk_bf16(a1[2], a1[3]);
            Af[rt][ks] = __builtin_bit_cast(bf16x8, pk);
        }
    }
#pragma unroll 1
    for (int nt = 0; nt < 5; ++nt) {
        const int c = HD * h + 16 * nt + m;
        bf16x8 Ba[3], Bx[3];
#pragma unroll
        for (int ks = 0; ks < 3; ++ks) {
            Ba[ks] = *(const bf16x8*)(GW + ((size_t)((h * 2 + 0) * HD + 16 * nt + m)) * 96 + 32 * ks + 8 * q);
            Bx[ks] = *(const bf16x8*)(GW + ((size_t)((h * 2 + 1) * HD + 16 * nt + m)) * 96 + 32 * ks + 8 * q);
        }
        bf16x8 Iq;
#pragma unroll
        for (int j = 0; j < 8; ++j) Iq[j] = (8 * q + j == 16 * (nt & 1) + m) ? (short)0x3F80 : (short)0;
        f32x4 ar[4], ax[4], ac[4];
#pragma unroll
        for (int rt = 0; rt < 4; ++rt) {
            ar[rt] = (f32x4){0.f, 0.f, 0.f, 0.f}; ax[rt] = ar[rt]; ac[rt] = ar[rt];
#pragma unroll
            for (int ks = 0; ks < 3; ++ks) {
                ar[rt] = __builtin_amdgcn_mfma_f32_16x16x32_bf16(Af[rt][ks], Ba[ks], ar[rt], 0, 0, 0);
                ax[rt] = __builtin_amdgcn_mfma_f32_16x16x32_bf16(Af[rt][ks], Bx[ks], ax[rt], 0, 0, 0);
            }
            const bf16x8 Asel = (nt < 2) ? Af[rt][0] : ((nt < 4) ? Af[rt][1] : Af[rt][2]);
            ac[rt] = __builtin_amdgcn_mfma_f32_16x16x32_bf16(Asel, Iq, ac[rt], 0, 0, 0);
        }
        const float ba = ga_b[c], bx = gx_b[c];
        const float kc = -8.0f * log1pf(__expf(-lam[c])) * LOG2E;
        float hl = 0.f, ca = 1.f; float hs[16], cs[16];
#pragma unroll
        for (int rt = 0; rt < 4; ++rt)
#pragma unroll
            for (int i = 0; i < 4; ++i) {
                const float r = pg8::sigmoidf_(ar[rt][i] + ba), ig = pg8::sigmoidf_(ax[rt][i] + bx);
                const float a = pg8::fast_exp2(r * kc);
                const float mult = __builtin_amdgcn_sqrtf(fmaxf(1.0f - a * a, 0.f));
                const float uu = mult * ig * ac[rt][i];
                hl = a * hl + uu; ca *= a;
                if (PASS2) { hs[4 * rt + i] = hl; cs[4 * rt + i] = ca; }
            }
        const float A0 = __shfl(ca, m), H0 = __shfl(hl, m), A1 = __shfl(ca, m + 16), H1 = __shfl(hl, m + 16), A2 = __shfl(ca, m + 32), H2 = __shfl(hl, m + 32);
        if (!PASS2) {
            const float A3 = __shfl(ca, m + 48), H3 = __shfl(hl, m + 48);
            float s = H0; s = A1 * s + H1; s = A2 * s + H2; s = A3 * s + H3;
            const float P = (A0 * A1) * (A2 * A3);
            if (q == 0) *(f32x2*)(AGG + ((size_t)cn * DR + c) * 2) = (f32x2){P, s};
        } else {
            const float s0 = CARRY[(size_t)cn * DR + c];
            const float s1 = A0 * s0 + H0, s2 = A1 * s1 + H1, s3 = A2 * s2 + H2;
            const float sq = q == 0 ? s0 : (q == 1 ? s1 : (q == 2 ? s2 : s3));
#pragma unroll
            for (int st = 0; st < 16; ++st) {
                const size_t off = (size_t)(row0 + 16 * q + st) * DR + c;
                const float hv = hs[st] + cs[st] * sq;
                const float gv = __uint_as_float((unsigned)G[off] << 16);
                Y[off] = (bf16_t)(cvt_pk_bf16(hv * gv, 0.f) & 0xffffu);
            }
        }
    }
}

constexpr int LDV = 136;
__device__ __forceinline__ void sgu_unit(LAS unsigned char* lds, int u, int tid, int lane, int wave, const bf16_t* U, const bf16_t* V, bf16_t* Y,
                                         const float* ssv, const float* ng, const bf16_t* WSb, const float* sbias) {
    const int g = u & 7, cn = u >> 3, row0 = cn * 128;
    LAS bf16_t* vt = (LAS bf16_t*)lds;
    {
        const int c0 = 8 * (tid & 15);
        const f32x4 g0 = *(const f32x4*)(ng + g * 128 + c0), g1 = *(const f32x4*)(ng + g * 128 + c0 + 4);
#pragma unroll
        for (int i = 0; i < 2; ++i) {
            const int s = 2 * ((tid >> 4) + 32 * i);
            const u32x4 va = *(const u32x4*)(V + (size_t)(row0 + s) * D + g * 128 + c0), vb = *(const u32x4*)(V + (size_t)(row0 + s + 1) * D + g * 128 + c0);
            float sa = 0.f, sb = 0.f;
#pragma unroll
            for (int k = 0; k < 4; ++k) { const f32x4 pa = *(const f32x4*)(ssv + (size_t)(row0 + s) * 16 + 4 * k), pb = *(const f32x4*)(ssv + (size_t)(row0 + s + 1) * 16 + 4 * k);
                sa += (pa[0] + pa[1]) + (pa[2] + pa[3]); sb += (pb[0] + pb[1]) + (pb[2] + pb[3]); }
            const float ra = __builtin_amdgcn_rsqf(sa * (1.0f / 1024.0f) + EPS), rb = __builtin_amdgcn_rsqf(sb * (1.0f / 1024.0f) + EPS);
            LAS unsigned* dst = (LAS unsigned*)(vt + s);
            dst[(c0 + 0) * (LDV / 2)] = cvt_pk_bf16(bf_lo(va.x) * ra * g0[0], bf_lo(vb.x) * rb * g0[0]);
            dst[(c0 + 1) * (LDV / 2)] = cvt_pk_bf16(bf_hi(va.x) * ra * g0[1], bf_hi(vb.x) * rb * g0[1]);
            dst[(c0 + 2) * (LDV / 2)] = cvt_pk_bf16(bf_lo(va.y) * ra * g0[2], bf_lo(vb.y) * rb * g0[2]);
            dst[(c0 + 3) * (LDV / 2)] = cvt_pk_bf16(bf_hi(va.y) * ra * g0[3], bf_hi(vb.y) * rb * g0[3]);
            dst[(c0 + 4) * (LDV / 2)] = cvt_pk_bf16(bf_lo(va.z) * ra * g1[0], bf_lo(vb.z) * rb * g1[0]);
            dst[(c0 + 5) * (LDV / 2)] = cvt_pk_bf16(bf_hi(va.z) * ra * g1[1], bf_hi(vb.z) * rb * g1[1]);
            dst[(c0 + 6) * (LDV / 2)] = cvt_pk_bf16(bf_lo(va.w) * ra * g1[2], bf_lo(vb.w) * rb * g1[2]);
            dst[(c0 + 7) * (LDV / 2)] = cvt_pk_bf16(bf_hi(va.w) * ra * g1[3], bf_hi(vb.w) * rb * g1[3]);
        }
    }
    __syncthreads();
    {
        const int m = lane & 15, q = lane >> 4, t = 16 * wave + m, kmax = wave >> 1;
        bf16x8 Bw[4];
#pragma unroll
        for (int ks = 0; ks < 4; ++ks) { Bw[ks] = (bf16x8){0, 0, 0, 0, 0, 0, 0, 0}; if (ks <= kmax) Bw[ks] = *(const bf16x8*)(WSb + ((size_t)(g * 128 + t)) * 128 + 32 * ks + 8 * q); }
        const float bias = sbias[g * 128 + t];
#pragma unroll
        for (int p = 0; p < 4; ++p) {
            f32x4 ac[2];
#pragma unroll
            for (int e = 0; e < 2; ++e) {
                ac[e] = (f32x4){0.f, 0.f, 0.f, 0.f};
                const int cc = 32 * p + 8 * (m >> 2) + 4 * e + (m & 3);
#pragma unroll
                for (int ks = 0; ks < 4; ++ks) if (ks <= kmax) {
                    const bf16x8 Afr = *(const LAS bf16x8*)(vt + cc * LDV + 32 * ks + 8 * q);
                    ac[e] = __builtin_amdgcn_mfma_f32_16x16x32_bf16(Afr, Bw[ks], ac[e], 0, 0, 0);
                }
            }
            const size_t off = (size_t)(row0 + t) * D + g * 128 + 32 * p + 8 * q;
            const u32x4 uv = *(const u32x4*)(U + off);
            u32x4 o;
            o.x = cvt_pk_bf16(bf_lo(uv.x) * (ac[0][0] + bias), bf_hi(uv.x) * (ac[0][1] + bias));
            o.y = cvt_pk_bf16(bf_lo(uv.y) * (ac[0][2] + bias), bf_hi(uv.y) * (ac[0][3] + bias));
            o.z = cvt_pk_bf16(bf_lo(uv.z) * (ac[1][0] + bias), bf_hi(uv.z) * (ac[1][1] + bias));
            o.w = cvt_pk_bf16(bf_lo(uv.w) * (ac[1][2] + bias), bf_hi(uv.w) * (ac[1][3] + bias));
            *(u32x4*)(Y + off) = o;
        }
    }
    __syncthreads();
}


#define XB_TMO      128
#define XB_XCNT(j)  (256  + 64 * (j))
#define XB_XSUB(j)  (1280 + 64 * (j))
#define XB_XGEN(j)  (2304 + 64 * (j))
#define XB_TOP      3328
#define XB_TOPGEN   3392
#define XCD_BAR_WORDS 3456
#define XB_SPIN_CAP (1u << 18)
__device__ __forceinline__ unsigned xb_ld(unsigned* p)              { return __hip_atomic_load(p, __ATOMIC_RELAXED, __HIP_MEMORY_SCOPE_AGENT); }
__device__ __forceinline__ unsigned xb_add(unsigned* p, unsigned v) { return __hip_atomic_fetch_add(p, v, __ATOMIC_RELAXED, __HIP_MEMORY_SCOPE_AGENT); }
__device__ __forceinline__ unsigned xb_xcc_id() { return (unsigned)__builtin_amdgcn_s_getreg((3 << 11) | 20) & 0xFu; }
#define XB_SPIN(cond, bar) do { unsigned _sp = 0; while (cond) { __builtin_amdgcn_s_sleep(1); \
    if ((++_sp & 255u) == 0u) { if (xb_ld(&(bar)[XB_TMO])) break; if (_sp > XB_SPIN_CAP) { atomicAdd(&(bar)[XB_TMO], 1u); break; } } } } while (0)
struct XcdBarrier { unsigned* bar; unsigned x; volatile LAS unsigned* st; };
__device__ __forceinline__ XcdBarrier xcd_barrier_post(unsigned* bar, volatile LAS unsigned* st) {
    XcdBarrier b; b.bar = bar; b.x = xb_xcc_id(); b.st = st;
    if (threadIdx.x == 0) (void)xb_add(&bar[XB_XCNT(b.x)], 1u);
    return b;
}
__device__ __forceinline__ void xcd_barrier_complete(unsigned* bar, unsigned x, unsigned& nloc, unsigned& nx) {
    const unsigned G = gridDim.x * gridDim.y * gridDim.z;
    unsigned sum, cnt, mine, sp = 0u;
    for (;;) {
        sum = 0u; cnt = 0u; mine = 0u;
#pragma unroll
        for (unsigned j = 0; j < 16; ++j) { const unsigned c = xb_ld(&bar[XB_XCNT(j)]); sum += c; cnt += (c > 0u) ? 1u : 0u; mine = (j == x) ? c : mine; }
        if (sum == G) break;
        __builtin_amdgcn_s_sleep(1);
        if ((++sp & 255u) == 0u) { if (xb_ld(&bar[XB_TMO])) break; if (sp > XB_SPIN_CAP) { atomicAdd(&bar[XB_TMO], 1u); break; } }
    }
    nloc = mine > 0u ? mine : 1u; nx = cnt > 0u ? cnt : 1u;
}
__device__ __forceinline__ void xcd_barrier(const XcdBarrier& b) {
    asm volatile("s_waitcnt vmcnt(0)" ::: "memory");
    __syncthreads();
    if (threadIdx.x == 0) {
        unsigned* bar = b.bar;
        __builtin_amdgcn_s_waitcnt(0);
        unsigned nloc = b.st[0], nx = b.st[1];
        if (nloc == 0u) { xcd_barrier_complete(bar, b.x, nloc, nx); b.st[0] = nloc; b.st[1] = nx; }
        const unsigned old = xb_add(&bar[XB_XSUB(b.x)], 1u);
        const unsigned gen = old / nloc;
        if (old + 1u == (gen + 1u) * nloc) {
            __builtin_amdgcn_fence(__ATOMIC_RELEASE, "agent");
            asm volatile("s_waitcnt vmcnt(0)" ::: "memory");
            const unsigned og = xb_add(&bar[XB_TOP], 1u);
            const unsigned tg = og / nx;
            if (og + 1u == (tg + 1u) * nx) xb_add(&bar[XB_TOPGEN], 1u);
            else XB_SPIN(xb_ld(&bar[XB_TOPGEN]) == tg, bar);
            __builtin_amdgcn_fence(__ATOMIC_ACQUIRE, "agent");
            xb_add(&bar[XB_XGEN(b.x)], 1u);
            asm volatile("s_waitcnt vmcnt(0)" ::: "memory");
        } else {
            XB_SPIN(xb_ld(&bar[XB_XGEN(b.x)]) == gen, bar);
            __builtin_amdgcn_fence(__ATOMIC_ACQUIRE, "agent");
            asm volatile("s_waitcnt vmcnt(0)" ::: "memory");
        }
    }
    __syncthreads();
}

__global__ void __launch_bounds__(512, 2) trunk_fwd(Args args) {
    extern __shared__ __attribute__((aligned(16))) unsigned char lds_raw[];
    LAS unsigned char* lds = (LAS unsigned char*)lds_raw;
    const int G_ = gridDim.x, bx = blockIdx.x;
    const int NGW = G_ * 8, NGT = G_ * 512;
#define PHASE_IDS() int tid = threadIdx.x; asm volatile("" : "+v"(tid)); const int lane = tid & 63, wave = __builtin_amdgcn_readfirstlane(tid >> 6), gw = bx * 8 + wave, gtid = bx * 512 + tid; (void)lane; (void)wave; (void)gw; (void)gtid
    unsigned char* ws = args.ws;
    float* X = args.out;
    float* SSP = (float*)(ws + WS_SSP);
    bf16_t* XB = (bf16_t*)(ws + WS_XB);
    unsigned char* BIG = ws + WS_BIG;
    const int lo = args.lo, hi = args.hi;
    int ph = 0;
#define RUN() (ph >= lo && ph < hi)
    volatile LAS unsigned* bst = (volatile LAS unsigned*)(lds + 131072);
    if (threadIdx.x < 2) bst[threadIdx.x] = 0u;
    __syncthreads();
    XcdBarrier xbar; xbar.bar = (unsigned*)(ws + WS_BAR); xbar.x = 0; xbar.st = bst;
#define SEAM() do { ++ph; if (ph > lo && ph < hi) { if (ph == 1) { cg::this_grid().sync(); xbar = xcd_barrier_post((unsigned*)(ws + WS_BAR), bst); } else xcd_barrier(xbar); } } while (0)

    _Pragma("unroll 1") for (int rep_ = 0; rep_ < (RUN() ? REP_0 : 0); ++rep_) { PHASE_IDS();
        if (bx == 0) for (int i = tid; i < XCD_BAR_WORDS; i += 512) ((unsigned*)(ws + WS_BAR))[i] = 0u;
        LAS float* scr = (LAS float*)(lds + wave * 16384);
        {
            f32x4 R0[8], R1[8];
            int it = gw;
            if (it < P0_NITEMS) { const P0Item d = p0_decode(args, ws, it); p0_load(d, lane, R0); }
#pragma unroll 1
            for (; it < P0_NITEMS; it += 2 * NGW) {
                const int it1 = it + NGW, it2 = it + 2 * NGW;
                if (it1 < P0_NITEMS) { const P0Item d1 = p0_decode(args, ws, it1); p0_load(d1, lane, R1); }
                { const P0Item d = p0_decode(args, ws, it); p0_store(d, lane, R0, scr); }
                if (it2 < P0_NITEMS) { const P0Item d2 = p0_decode(args, ws, it2); p0_load(d2, lane, R0); }
                if (it1 < P0_NITEMS) { const P0Item d1 = p0_decode(args, ws, it1); p0_store(d1, lane, R1, scr); }
            }
        }
        for (int id = gtid; id < 2 * NH * 2 * HD * 12; id += NGT) {
            const int k8 = id % 12, n = (id / 12) % HD, qq = (id / (12 * HD)) & 1, jh = id / (12 * HD * 2);
            const float* Wg = (qq ? args.in[9] : args.in[7]) + (size_t)jh * HD * HD;
            float v[8];
#pragma unroll
            for (int j = 0; j < 8; ++j) { const int k = 8 * k8 + j; v[j] = (k < HD) ? Wg[k * HD + n] : 0.f; }
            u32x4 o; o.x = cvt_pk_bf16(v[0], v[1]); o.y = cvt_pk_bf16(v[2], v[3]); o.z = cvt_pk_bf16(v[4], v[5]); o.w = cvt_pk_bf16(v[6], v[7]);
            *(u32x4*)((bf16_t*)(ws + WS_GW) + (size_t)id * 8) = o;
        }
        for (int id = gtid; id < 8 * 128 * 16; id += NGT) {
            const int s8 = id & 15, t = (id >> 4) & 127;
            const float* p = args.in[15] + (size_t)id * 8; float v[8];
#pragma unroll
            for (int j = 0; j < 8; ++j) v[j] = (8 * s8 + j <= t) ? p[j] : 0.f;
            u32x4 o; o.x = cvt_pk_bf16(v[0], v[1]); o.y = cvt_pk_bf16(v[2], v[3]); o.z = cvt_pk_bf16(v[4], v[5]); o.w = cvt_pk_bf16(v[6], v[7]);
            *(u32x4*)((bf16_t*)(ws + WS_WSB) + (size_t)id * 8) = o;
        }
        const float* x = args.in[0];
        for (int r = gw; r < M; r += 2 * NGW) {
            const int r1 = r + NGW;
            f32x4 va[4], vb[4];
#pragma unroll
            for (int j = 0; j < 4; ++j) { va[j] = __builtin_nontemporal_load((const f32x4*)(x + (size_t)r * D) + lane + 64 * j); vb[j] = (r1 < M) ? __builtin_nontemporal_load((const f32x4*)(x + (size_t)r1 * D) + lane + 64 * j) : (f32x4){0.f, 0.f, 0.f, 0.f}; }
            float sa = 0.f, sb = 0.f;
            unsigned long long* oa = (unsigned long long*)(XB + (size_t)r * D) + lane; unsigned long long* ob = (unsigned long long*)(XB + (size_t)r1 * D) + lane;
#pragma unroll
            for (int j = 0; j < 4; ++j) {
                sa += (va[j][0] * va[j][0] + va[j][1] * va[j][1]) + (va[j][2] * va[j][2] + va[j][3] * va[j][3]);
                sb += (vb[j][0] * vb[j][0] + vb[j][1] * vb[j][1]) + (vb[j][2] * vb[j][2] + vb[j][3] * vb[j][3]);
                oa[64 * j] = (unsigned long long)cvt_pk_bf16(va[j][0], va[j][1]) | ((unsigned long long)cvt_pk_bf16(va[j][2], va[j][3]) << 32);
                if (r1 < M) ob[64 * j] = (unsigned long long)cvt_pk_bf16(vb[j][0], vb[j][1]) | ((unsigned long long)cvt_pk_bf16(vb[j][2], vb[j][3]) << 32);
            }
            sa = wave_sum(sa); sb = wave_sum(sb);
            if (lane < 16) { SSP[(size_t)r * 16 + lane] = (lane == 0) ? sa : 0.f; if (r1 < M) SSP[(size_t)r1 * 16 + lane] = (lane == 0) ? sb : 0.f; }
        }
    }
    SEAM();

#pragma unroll 1
    for (int L = 0; L < 4; ++L) {
        const int kind = L % 3, j = L / 3;
        const float* xbase = (L == 0) ? args.in[0] : X;
        const bf16_t* Ymix; const bf16_t* Wout; int Kout;
        if (kind == 0) {
            bf16_t* Gb = (bf16_t*)(BIG + A_G); bf16_t* XRb = (bf16_t*)(BIG + A_XR); bf16_t* Yb = (bf16_t*)(BIG + A_Y);
            float* AGG = (float*)(BIG + A_AGG); float* CARRY = (float*)(BIG + A_CARRY);
            _Pragma("unroll 1") for (int rep_ = 0; rep_ < (RUN() ? REP_1 : 0); ++rep_) { PHASE_IDS();
                pg8::Gemm g{XB, (const bf16_t*)(ws + W_AWIN) + (size_t)j * D * 2 * DR, M, 2 * DR, D}; pg8::StaticOrder S; S.init(M, 2 * DR, G_, bx);
                pg8::EpiAct<0> E{Gb, DR, DR, (size_t)(A_XR - A_G) / 2, SSP, nullptr};
                pg8::gemm_phase<pg8::EpiAct<0>, pg8::StaticOrder>(lds, g, S, E);
            }
            SEAM();
            const float* cw = args.in[5] + (size_t)j * 4 * DR; const float* cb = args.in[6] + (size_t)j * DR;
            const bf16_t* GWl = (const bf16_t*)(ws + WS_GW) + (size_t)j * NH * 2 * HD * 96;
            const float* gab = args.in[8] + (size_t)j * DR; const float* gxb = args.in[10] + (size_t)j * DR; const float* lam = args.in[11] + (size_t)j * DR;
            _Pragma("unroll 1") for (int rep_ = 0; rep_ < (RUN() ? REP_2 : 0); ++rep_) { PHASE_IDS();
#pragma unroll 1
                for (int u = gw; u < 256 * NH; u += NGW) a_unit<false>(u, lane, XRb, Gb, Yb, AGG, CARRY, cw, cb, GWl, gab, gxb, lam);
            }
            SEAM();
            _Pragma("unroll 1") for (int rep_ = 0; rep_ < (RUN() ? REP_3 : 0); ++rep_) { PHASE_IDS();
                if (gtid < 2 * DR) {
                    const int b = gtid / DR, c = gtid % DR; float s = 0.f;
#pragma unroll 1
                    for (int n0 = 0; n0 < 128; n0 += 16) {
                        f32x2 pv[16];
#pragma unroll
                        for (int i = 0; i < 16; ++i) pv[i] = *(const f32x2*)(AGG + ((size_t)(b * 128 + n0 + i) * DR + c) * 2);
#pragma unroll
                        for (int i = 0; i < 16; ++i) { CARRY[(size_t)(b * 128 + n0 + i) * DR + c] = s; s = pv[i][0] * s + pv[i][1]; }
                    }
                }
            }
            SEAM();
            _Pragma("unroll 1") for (int rep_ = 0; rep_ < (RUN() ? REP_4 : 0); ++rep_) { PHASE_IDS();
#pragma unroll 1
                for (int u = gw; u < 256 * NH; u += NGW) a_unit<true>(u, lane, XRb, Gb, Yb, AGG, CARRY, cw, cb, GWl, gab, gxb, lam);
            }
            SEAM();
            Ymix = Yb; Wout = (const bf16_t*)(ws + W_AWOUT) + (size_t)j * DR * D; Kout = DR;
        } else if (kind == 1) {
            bf16_t* Ub = (bf16_t*)(BIG + B_U); bf16_t* Vb = (bf16_t*)(BIG + B_V); bf16_t* Yb = (bf16_t*)(BIG + B_Y); float* SSV = (float*)(BIG + B_SSV);
            _Pragma("unroll 1") for (int rep_ = 0; rep_ < (RUN() ? REP_5 : 0); ++rep_) { PHASE_IDS();
                pg8::Gemm g{XB, (const bf16_t*)(ws + W_BWIN), M, 2 * D, D}; pg8::StaticOrder S; S.init(M, 2 * D, G_, bx);
                pg8::EpiAct<2> E{Ub, D, D, (size_t)(B_V - B_U) / 2, SSP, SSV};
                pg8::gemm_phase<pg8::EpiAct<2>, pg8::StaticOrder>(lds, g, S, E);
            }
            SEAM();
            _Pragma("unroll 1") for (int rep_ = 0; rep_ < (RUN() ? REP_6 : 0); ++rep_) { PHASE_IDS();
#pragma unroll 1
                for (int u = bx; u < 128 * 8; u += G_) sgu_unit(lds, u, tid, lane, wave, Ub, Vb, Yb, SSV, args.in[14], (const bf16_t*)(ws + WS_WSB), args.in[16]);
            }
            SEAM();
            Ymix = Yb; Wout = (const bf16_t*)(ws + W_BWOUT); Kout = D;
        } else {
            bf16_t* GCX = (bf16_t*)(BIG + C_GCX); bf16_t* Yb = (bf16_t*)(BIG + C_Y);
            _Pragma("unroll 1") for (int rep_ = 0; rep_ < (RUN() ? REP_7 : 0); ++rep_) { PHASE_IDS();
                pg8::Gemm g{XB, (const bf16_t*)(ws + W_CWIN), M, 3 * D, D}; pg8::StaticOrder S; S.init(M, 3 * D, G_, bx);
                pg8::EpiAct<3> E{GCX, 3 * D, 0, 0, SSP, nullptr};
                pg8::gemm_phase<pg8::EpiAct<3>, pg8::StaticOrder>(lds, g, S, E);
            }
            SEAM();
            _Pragma("unroll 1") for (int rep_ = 0; rep_ < (RUN() ? REP_8 : 0); ++rep_) { PHASE_IDS();
                const float* cw = args.in[19];
                for (int id = gtid; id < (M / 16) * 128; id += NGT) {
                    const int cgp = id & 127, r = id >> 7, c0 = 8 * cgp, rowb = r * 16;
                    f32x4 w[3][2];
#pragma unroll
                    for (int k = 0; k < 3; ++k) { w[k][0] = *(const f32x4*)(cw + k * D + c0); w[k][1] = *(const f32x4*)(cw + k * D + c0 + 4); }
                    float p2[8], p1[8];
#pragma unroll
                    for (int jj = 0; jj < 8; ++jj) { p2[jj] = 0.f; p1[jj] = 0.f; }
                    if ((rowb & (SEQ - 1)) != 0) {
                        const u32x4 ga = *(const u32x4*)(GCX + (size_t)(rowb - 2) * 3 * D + D + c0), xa = *(const u32x4*)(GCX + (size_t)(rowb - 2) * 3 * D + 2 * D + c0);
                        const u32x4 gb_ = *(const u32x4*)(GCX + (size_t)(rowb - 1) * 3 * D + D + c0), xb_ = *(const u32x4*)(GCX + (size_t)(rowb - 1) * 3 * D + 2 * D + c0);
                        p2[0] = bf_lo(ga.x) * bf_lo(xa.x); p2[1] = bf_hi(ga.x) * bf_hi(xa.x); p2[2] = bf_lo(ga.y) * bf_lo(xa.y); p2[3] = bf_hi(ga.y) * bf_hi(xa.y);
                        p2[4] = bf_lo(ga.z) * bf_lo(xa.z); p2[5] = bf_hi(ga.z) * bf_hi(xa.z); p2[6] = bf_lo(ga.w) * bf_lo(xa.w); p2[7] = bf_hi(ga.w) * bf_hi(xa.w);
                        p1[0] = bf_lo(gb_.x) * bf_lo(xb_.x); p1[1] = bf_hi(gb_.x) * bf_hi(xb_.x); p1[2] = bf_lo(gb_.y) * bf_lo(xb_.y); p1[3] = bf_hi(gb_.y) * bf_hi(xb_.y);
                        p1[4] = bf_lo(gb_.z) * bf_lo(xb_.z); p1[5] = bf_hi(gb_.z) * bf_hi(xb_.z); p1[6] = bf_lo(gb_.w) * bf_lo(xb_.w); p1[7] = bf_hi(gb_.w) * bf_hi(xb_.w);
                    }
#pragma unroll 4
                    for (int t = 0; t < 16; ++t) {
                        const size_t ro = (size_t)(rowb + t) * 3 * D + c0;
                        const u32x4 bb = *(const u32x4*)(GCX + ro), gc = *(const u32x4*)(GCX + ro + D), xv = *(const u32x4*)(GCX + ro + 2 * D);
                        float p0[8], gbv[8];
                        p0[0] = bf_lo(gc.x) * bf_lo(xv.x); p0[1] = bf_hi(gc.x) * bf_hi(xv.x); p0[2] = bf_lo(gc.y) * bf_lo(xv.y); p0[3] = bf_hi(gc.y) * bf_hi(xv.y);
                        p0[4] = bf_lo(gc.z) * bf_lo(xv.z); p0[5] = bf_hi(gc.z) * bf_hi(xv.z); p0[6] = bf_lo(gc.w) * bf_lo(xv.w); p0[7] = bf_hi(gc.w) * bf_hi(xv.w);
                        gbv[0] = bf_lo(bb.x); gbv[1] = bf_hi(bb.x); gbv[2] = bf_lo(bb.y); gbv[3] = bf_hi(bb.y); gbv[4] = bf_lo(bb.z); gbv[5] = bf_hi(bb.z); gbv[6] = bf_lo(bb.w); gbv[7] = bf_hi(bb.w);
                        float y[8];
#pragma unroll
                        for (int jj = 0; jj < 8; ++jj) { y[jj] = gbv[jj] * (w[0][jj >> 2][jj & 3] * p2[jj] + w[1][jj >> 2][jj & 3] * p1[jj] + w[2][jj >> 2][jj & 3] * p0[jj]); p2[jj] = p1[jj]; p1[jj] = p0[jj]; }
                        u32x4 o; o.x = cvt_pk_bf16(y[0], y[1]); o.y = cvt_pk_bf16(y[2], y[3]); o.z = cvt_pk_bf16(y[4], y[5]); o.w = cvt_pk_bf16(y[6], y[7]);
                        *(u32x4*)(Yb + (size_t)(rowb + t) * D + c0) = o;
                    }
                }
            }
            SEAM();
            Ymix = Yb; Wout = (const bf16_t*)(ws + W_CWOUT); Kout = D;
        }
        _Pragma("unroll 1") for (int rep_ = 0; rep_ < (RUN() ? REP_9 : 0); ++rep_) { PHASE_IDS();
            pg8::Gemm g{Ymix, Wout, M, D, Kout}; pg8::StaticOrder S; S.init(M, D, G_, bx);
            pg8::EpiRes E{xbase, X, XB, SSP};
            pg8::gemm_phase<pg8::EpiRes, pg8::StaticOrder>(lds, g, S, E);
        }
        SEAM();
        _Pragma("unroll 1") for (int rep_ = 0; rep_ < (RUN() ? REP_10 : 0); ++rep_) { PHASE_IDS();
            pg8::Gemm g{XB, (const bf16_t*)(ws + W_W1) + (size_t)L * D * FF, M, FF, D}; pg8::StaticOrder S; S.init(M, FF, G_, bx);
            pg8::EpiAct<1> E{(bf16_t*)BIG, FF, 0, 0, SSP, nullptr};
            pg8::gemm_phase<pg8::EpiAct<1>, pg8::StaticOrder>(lds, g, S, E);
        }
        SEAM();
        _Pragma("unroll 1") for (int rep_ = 0; rep_ < (RUN() ? REP_11 : 0); ++rep_) { PHASE_IDS();
            pg8::Gemm g{(const bf16_t*)BIG, (const bf16_t*)(ws + W_W2) + (size_t)L * FF * D, M, D, FF}; pg8::StaticOrder S; S.init(M, D, G_, bx);
            pg8::EpiRes E{X, X, XB, SSP};
            pg8::gemm_phase<pg8::EpiRes, pg8::StaticOrder>(lds, g, S, E);
        }
        SEAM();
    }
    _Pragma("unroll 1") for (int rep_ = 0; rep_ < (RUN() ? REP_12 : 0); ++rep_) { PHASE_IDS();
        const float* fg = args.in[3];
        for (int r = gw; r < M; r += NGW) {
            float s = (lane < 16) ? SSP[(size_t)r * 16 + lane] : 0.f;
            s = wave_sum(s);
            const float rs = __builtin_amdgcn_rsqf(s * (1.0f / 1024.0f) + EPS);
            f32x4* xr = (f32x4*)(X + (size_t)r * D) + lane; const f32x4* gr = (const f32x4*)fg + lane;
#pragma unroll
            for (int jj = 0; jj < 4; ++jj) { const f32x4 v = xr[64 * jj], gg = gr[64 * jj]; xr[64 * jj] = v * rs * gg; }
        }
    }
#undef RUN
#undef SEAM
}

extern "C" void kernel_launch(void* const* d_in, const int* in_sizes, int n_in, void* d_out, int out_size, void* d_ws, size_t ws_size, hipStream_t stream) {
    static int grid = 0;
    if (grid == 0) {
        if (n_in != 23 || in_sizes[0] != M * D || out_size != M * D || ws_size < WS_END) {
            fprintf(stderr, "kernel_launch: unexpected shapes (n_in %d, in0 %d, out %d, ws %zu < %zu); nothing launched\n", n_in, n_in > 0 ? in_sizes[0] : -1, out_size, ws_size, (size_t)WS_END); grid = -1; return; }
        int dev = 0, cus = 0, per_cu = 0;
        if (hipGetDevice(&dev) != hipSuccess || hipDeviceGetAttribute(&cus, hipDeviceAttributeMultiprocessorCount, dev) != hipSuccess) { grid = -1; return; }
        if (hipFuncSetAttribute((const void*)trunk_fwd, hipFuncAttributeMaxDynamicSharedMemorySize, LDS_BYTES) != hipSuccess) { fprintf(stderr, "kernel_launch: hipFuncSetAttribute failed\n"); grid = -1; return; }
        if (hipOccupancyMaxActiveBlocksPerMultiprocessor(&per_cu, (const void*)trunk_fwd, 512, LDS_BYTES) != hipSuccess || per_cu < 1) { fprintf(stderr, "kernel_launch: occupancy query gave %d\n", per_cu); per_cu = 1; }
        (void)hipGetLastError();
        grid = cus * per_cu;
    }
    if (grid < 0) return;
    Args a{};
    for (int i = 0; i < 23; ++i) a.in[i] = (const float*)d_in[i];
    a.out = (float*)d_out; a.ws = (unsigned char*)d_ws;
#if MK_MULTI
    for (int p = 0; p < NPHASE; ++p) { a.lo = p; a.hi = p + 1; hipLaunchKernelGGL(trunk_fwd, dim3(grid), dim3(512), LDS_BYTES, stream, a); }
#else
    a.lo = 0; a.hi = NPHASE;
    void* kargs[] = {(void*)&a};
    hipError_t e = hipLaunchCooperativeKernel((const void*)trunk_fwd, dim3(grid), dim3(512), kargs, LDS_BYTES, stream);
    if (e != hipSuccess) fprintf(stderr, "kernel_launch: cooperative launch failed: %s (grid %d)\n", hipGetErrorString(e), grid);
#endif
}
```

```cpp
#include <hip/hip_runtime.h>
#include <hip/hip_cooperative_groups.h>
#include <cstdio>
#include <cstdint>
namespace cg = cooperative_groups;

#ifndef PHMASK
#define PHMASK 0xFFFFFFFFu
#endif
#ifndef REP_0
#define REP_0 1
#endif
#ifndef REP_1
#define REP_1 1
#endif
#ifndef REP_2
#define REP_2 1
#endif
#ifndef REP_3
#define REP_3 1
#endif
#ifndef REP_4
#define REP_4 1
#endif
#ifndef REP_5
#define REP_5 1
#endif
#ifndef REP_6
#define REP_6 1
#endif
#ifndef REP_7
#define REP_7 1
#endif
#ifndef REP_8
#define REP_8 1
#endif
#ifndef REP_9
#define REP_9 1
#endif
#ifndef REP_10
#define REP_10 1
#endif
#ifndef REP_11
#define REP_11 1
#endif
#ifndef REP_12
#define REP_12 1
#endif
#ifndef MK_MULTI
#define MK_MULTI 0
#endif

#define LAS __attribute__((address_space(3)))
typedef unsigned short bf16_t;
typedef short bf16x8 __attribute__((ext_vector_type(8)));
typedef float f32x4 __attribute__((ext_vector_type(4)));
typedef float f32x2 __attribute__((ext_vector_type(2)));
typedef unsigned u32x4 __attribute__((ext_vector_type(4)));
typedef unsigned u32x2 __attribute__((ext_vector_type(2)));

constexpr int SEQ = 8192, M = 2 * SEQ, D = 1024, DR = 1280, FF = 4096, NH = 16, HD = 80;
constexpr float EPS = 1e-6f, LOG2E = 1.4426950408889634f;
constexpr int NPHASE = 24;

constexpr size_t MiB = 1u << 20;
constexpr size_t WS_SSP = 0;
constexpr size_t WS_GW = 1 * MiB;
constexpr size_t WS_BAR = 1 * MiB + 983040;
constexpr size_t WS_WSB = 2 * MiB;
constexpr size_t WS_W = 2 * MiB + 256 * 1024;
constexpr size_t W_AWIN = WS_W, W_AWOUT = WS_W + 10 * MiB, W_BWIN = WS_W + 15 * MiB, W_BWOUT = WS_W + 19 * MiB, W_CWIN = WS_W + 21 * MiB,
                 W_CWOUT = WS_W + 27 * MiB, W_W1 = WS_W + 29 * MiB, W_W2 = WS_W + 61 * MiB;
constexpr size_t WS_XB = WS_W + 93 * MiB;
constexpr size_t WS_BIG = WS_XB + 32 * MiB;
constexpr size_t WS_END = WS_BIG + 128 * MiB;
constexpr size_t A_G = 0, A_XR = 40 * MiB, A_Y = 80 * MiB, A_AGG = 120 * MiB, A_CARRY = 124 * MiB;
constexpr size_t B_U = 0, B_V = 32 * MiB, B_Y = 64 * MiB, B_SSV = 96 * MiB;
constexpr size_t C_GCX = 0, C_Y = 96 * MiB;

constexpr int LDS_BYTES = 147456;

namespace pg8 {
constexpr int BM = 256, BK = 64, HALF = 128, HTB = HALF * BK * 2, STAGE_BYTES = 8 * HTB, NXCD = 8, WGM = 8;
__host__ __device__ __forceinline__ int lds_byte(int r, int c) { const int st = (r >> 4) * 2 + (c >> 5), rr = r & 15, cc = c & 31, ob = rr * 64 + cc * 2; return st * 1024 + (ob ^ (((ob >> 9) & 1) << 5)); }
__host__ __device__ __forceinline__ void stage_rc(int b, int& R, int& C) { const int st = b / 1024, sb = b % 1024, swz = sb ^ (((sb >> 9) & 1) << 5); R = (st >> 1) * 16 + swz / 64; C = (st & 1) * 32 + (swz % 64) / 2; }
__host__ __device__ __forceinline__ int perm32(int rho) { const int n = rho >> 4, i = rho & 15; return 8 * (i >> 2) + 4 * n + (i & 3); }

struct Unit { int pm, pn; };
struct Gemm { const bf16_t* A; const bf16_t* Bt; int M, N, K; };

struct StaticOrder {
    int nM, nN, nwg, G, c;
    __host__ __device__ void init(int M_, int N_, int G_, int c_) { nM = M_ / BM; nN = N_ / BM; nwg = nM * nN; G = G_; c = c_; }
    __host__ __device__ bool next(int i, Unit& u) const {
        const long L = (long)i * G + c; if (L >= nwg) return false;
        int wgid = (int)L; { const int q = nwg / NXCD, r = nwg % NXCD, xcd = wgid % NXCD, off = wgid / NXCD; wgid = (xcd < r ? xcd * (q + 1) : r * (q + 1) + (xcd - r) * q) + off; }
        const int nig = WGM * nN, gid = wgid / nig, fm = gid * WGM, gsz = (nM - fm) < WGM ? (nM - fm) : WGM;
        u.pm = fm + ((wgid % nig) % gsz); u.pn = (wgid % nig) / gsz; return true;
    }
};

__device__ __forceinline__ unsigned cvt_pk_bf16(float lo, float hi) { unsigned r; asm volatile("v_cvt_pk_bf16_f32 %0, %1, %2" : "=v"(r) : "v"(lo), "v"(hi)); return r; }
__device__ __forceinline__ float fast_rcp(float x) { return __builtin_amdgcn_rcpf(x); }
__device__ __forceinline__ float fast_exp2(float x) { return __builtin_amdgcn_exp2f(x); }
__device__ __forceinline__ float sigmoidf_(float z) { return fast_rcp(1.0f + fast_exp2(-LOG2E * z)); }
__device__ __forceinline__ float gelu_tanh(float x) { const float z = x * (1.0f + 0.044715f * x * x); return x * fast_rcp(1.0f + fast_exp2(-2.0f * 0.7978845608028654f * LOG2E * z)); }

__device__ __forceinline__ float row_rs(const float* ssp, int row, int fq) {
    const f32x4 p = *(const f32x4*)(ssp + (size_t)row * 16 + 4 * fq);
    float s = (p[0] + p[1]) + (p[2] + p[3]);
    s += __shfl_xor(s, 16); s += __shfl_xor(s, 32);
    return __builtin_amdgcn_rsqf(s * (1.0f / 1024.0f) + EPS);
}

template <int MODE> struct EpiAct {
    static constexpr bool PERM = true, AFTER_DRAIN = false;
    bf16_t* O; int ldc; int split_cols; size_t split_stride; const float* ssp; float* ssv;
    __device__ __forceinline__ void operator()(const f32x4 (&acc)[2][2][4][2], const Unit& u, int wr, int wc, int fr, int fq) const {
        const int row0 = u.pm * BM + wr * 64 + fr; int colt = u.pn * BM; bf16_t* base = O; int t = 0;
        if (split_cols) { t = colt / split_cols; base += (size_t)t * split_stride; colt -= t * split_cols; }
        const int col0 = colt + wc * 32 + 8 * fq;
#pragma unroll
        for (int ai = 0; ai < 2; ++ai)
#pragma unroll
            for (int m = 0; m < 4; ++m) {
                const int row = row0 + ai * HALF + m * 16;
                const float rs = row_rs(ssp, row, fq);
                bf16_t* rowp = base + (size_t)row * ldc + col0; float vs = 0.f;
#pragma unroll
                for (int bj = 0; bj < 2; ++bj) {
                    f32x4 v0 = acc[ai][bj][m][0] * rs, v1 = acc[ai][bj][m][1] * rs;
                    if (MODE == 0) { if (t == 0) {
#pragma unroll
                        for (int j = 0; j < 4; ++j) { v0[j] = gelu_tanh(v0[j]); v1[j] = gelu_tanh(v1[j]); } } }
                    if (MODE == 1) {
#pragma unroll
                        for (int j = 0; j < 4; ++j) { const float a = fmaxf(v0[j], 0.f), b = fmaxf(v1[j], 0.f); v0[j] = a * a; v1[j] = b * b; } }
                    if (MODE == 2) {
#pragma unroll
                        for (int j = 0; j < 4; ++j) { v0[j] = gelu_tanh(v0[j]); v1[j] = gelu_tanh(v1[j]); }
                        vs += (v0[0] * v0[0] + v0[1] * v0[1]) + (v0[2] * v0[2] + v0[3] * v0[3]) + (v1[0] * v1[0] + v1[1] * v1[1]) + (v1[2] * v1[2] + v1[3] * v1[3]); }
                    u32x4 w; w.x = cvt_pk_bf16(v0[0], v0[1]); w.y = cvt_pk_bf16(v0[2], v0[3]); w.z = cvt_pk_bf16(v1[0], v1[1]); w.w = cvt_pk_bf16(v1[2], v1[3]);
                    *(u32x4*)(rowp + bj * HALF) = w;
                }
                if (MODE == 2) { vs += __shfl_xor(vs, 16); vs += __shfl_xor(vs, 32);
                    if (t == 1 && fq == 0) ssv[(size_t)row * 16 + (u.pn - 4) * 4 + wc] = vs; }
            }
    }
};
struct EpiRes {
    static constexpr bool PERM = true, AFTER_DRAIN = false;
    const float* base; float* out; bf16_t* xb; float* ssp;
    __device__ __forceinline__ void operator()(const f32x4 (&acc)[2][2][4][2], const Unit& u, int wr, int wc, int fr, int fq) const {
        const int row0 = u.pm * BM + wr * 64 + fr, col0 = u.pn * BM + wc * 32 + 8 * fq;
#pragma unroll
        for (int ai = 0; ai < 2; ++ai)
#pragma unroll
            for (int m = 0; m < 4; ++m) {
                const int row = row0 + ai * HALF + m * 16; float ss = 0.f;
#pragma unroll
                for (int bj = 0; bj < 2; ++bj) {
                    const size_t off = (size_t)row * D + col0 + bj * HALF;
                    const f32x4 b0 = *(const f32x4*)(base + off), b1 = *(const f32x4*)(base + off + 4);
                    const f32x4 v0 = acc[ai][bj][m][0] + b0, v1 = acc[ai][bj][m][1] + b1;
                    *(f32x4*)(out + off) = v0; *(f32x4*)(out + off + 4) = v1;
                    ss += (v0[0] * v0[0] + v0[1] * v0[1]) + (v0[2] * v0[2] + v0[3] * v0[3]) + (v1[0] * v1[0] + v1[1] * v1[1]) + (v1[2] * v1[2] + v1[3] * v1[3]);
                    u32x4 w; w.x = cvt_pk_bf16(v0[0], v0[1]); w.y = cvt_pk_bf16(v0[2], v0[3]); w.z = cvt_pk_bf16(v1[0], v1[1]); w.w = cvt_pk_bf16(v1[2], v1[3]);
                    *(u32x4*)(xb + off) = w;
                }
                ss += __shfl_xor(ss, 16); ss += __shfl_xor(ss, 32);
                if (fq == 0) ssp[(size_t)row * 16 + u.pn * 4 + wc] = ss;
            }
    }
};

template <class Epi, class Sched, bool ALIGN_EPI = true>
__device__ __forceinline__ void gemm_phase(LAS unsigned char* lds, const Gemm g, const Sched& S, const Epi& E) {
    int tid_o = threadIdx.x; asm volatile("" : "+v"(tid_o));
    const int tid = tid_o, wid = __builtin_amdgcn_readfirstlane(tid >> 6), lane = tid & 63, wr = wid >> 2, wc = wid & 3, fr = lane & 15, fq = lane >> 4;
    const int K = g.K, nt = K / BK;
    unsigned voffA[2], voffB[2];
#pragma unroll
    for (int i = 0; i < 2; ++i) { int R, C; stage_rc(tid * 16 + i * 8192, R, C); const int Rb = Epi::PERM ? ((R & ~31) + perm32(R & 31)) : R;
        voffA[i] = (unsigned)(R * K + C) * 2u; voffB[i] = (unsigned)(Rb * K + C) * 2u; }
    const size_t kstep = (size_t)(BK * 2);
    const size_t hstep = (size_t)HALF * K * 2;
    const size_t tstep = 2 * hstep;
    const unsigned ldsw = (unsigned)wid * 1024u;
    const int aoff = lds_byte(wr * 64 + fr, fq * 8), boff = lds_byte(wc * 32 + fr, fq * 8);
#define PG8_SA(b, h) (((b) * 2 + (h)) * HTB)
#define PG8_SB(b, h) ((4 + (b) * 2 + (h)) * HTB)
#define PG8_STAGE(bufoff, gbase, voff) do { _Pragma("unroll") for (int _i = 0; _i < 2; ++_i) \
        __builtin_amdgcn_global_load_lds((const unsigned*)((const char*)(gbase) + (voff)[_i]), (LAS unsigned*)(lds + (bufoff) + ldsw + _i * 8192), 16, 0, 0); } while (0)
#define PG8_LDA(dst, b, h) do { _Pragma("unroll") for (int m = 0; m < 4; ++m) _Pragma("unroll") for (int k = 0; k < 2; ++k) dst[m][k] = *(const LAS bf16x8*)(lds + PG8_SA(b, h) + aoff + m * 2048 + k * 1024); } while (0)
#define PG8_LDB(dst, b, h) do { _Pragma("unroll") for (int n = 0; n < 2; ++n) _Pragma("unroll") for (int k = 0; k < 2; ++k) dst[n][k] = *(const LAS bf16x8*)(lds + PG8_SB(b, h) + boff + n * 2048 + k * 1024); } while (0)
#define PG8_MMA(ai, bj, At, Bt) do { __builtin_amdgcn_s_setprio(1); _Pragma("unroll") for (int m = 0; m < 4; ++m) _Pragma("unroll") for (int n = 0; n < 2; ++n) _Pragma("unroll") for (int k = 0; k < 2; ++k) \
        acc[ai][bj][m][n] = __builtin_amdgcn_mfma_f32_16x16x32_bf16(Bt[n][k], At[m][k], acc[ai][bj][m][n], 0, 0, 0); __builtin_amdgcn_s_setprio(0); } while (0)
#define PG8_WAIT_V(n) asm volatile("s_waitcnt vmcnt(" #n ")" ::: "memory")
#define PG8_WAIT_L(n) asm volatile("s_waitcnt lgkmcnt(" #n ")" ::: "memory")
#define PG8_BAR __builtin_amdgcn_s_barrier()
#define PG8_SCHED __builtin_amdgcn_sched_barrier(0)
    Unit cur, nxt; int ui = 0;
    if (!S.next(0, cur)) return;
    f32x4 acc[2][2][4][2];
#pragma unroll
    for (int a = 0; a < 2; ++a)
#pragma unroll
        for (int b = 0; b < 2; ++b)
#pragma unroll
            for (int m = 0; m < 4; ++m)
#pragma unroll
                for (int n = 0; n < 2; ++n) acc[a][b][m][n] = (f32x4){0.f, 0.f, 0.f, 0.f};
    bf16x8 At[4][2], B0[2][2], B1[2][2];
    const char* cA = (const char*)g.A + (size_t)cur.pm * tstep; const char* cB = (const char*)g.Bt + (size_t)cur.pn * tstep;
    PG8_STAGE(PG8_SB(0, 0), cB, voffB); PG8_STAGE(PG8_SB(0, 1), cB + hstep, voffB); PG8_STAGE(PG8_SA(0, 0), cA, voffA); PG8_STAGE(PG8_SA(0, 1), cA + hstep, voffA);
    if (wr == 1) PG8_BAR;
    PG8_WAIT_V(2); PG8_BAR;
    PG8_STAGE(PG8_SB(1, 0), cB + kstep, voffB); PG8_STAGE(PG8_SA(1, 0), cA + kstep, voffA); PG8_STAGE(PG8_SB(1, 1), cB + hstep + kstep, voffB);
    PG8_WAIT_V(6); PG8_BAR;
    for (;;) {
        const bool has_next = S.next(ui + 1, nxt);
        const char* nA = has_next ? (const char*)g.A + (size_t)nxt.pm * tstep : cA; const char* nB = has_next ? (const char*)g.Bt + (size_t)nxt.pn * tstep : cB;
        for (int t = 0; t < nt; t += 2) {
            const bool last = (t == nt - 2);
            const char* a1 = cA + (size_t)(t + 1) * kstep;
            const char* a2 = last ? nA : cA + (size_t)(t + 2) * kstep; const char* b2 = last ? nB : cB + (size_t)(t + 2) * kstep;
            const char* a3 = a2 + kstep; const char* b3 = b2 + kstep;
            PG8_LDB(B0, 0, 0); PG8_LDB(B1, 0, 1); PG8_SCHED; PG8_LDA(At, 0, 0); PG8_STAGE(PG8_SA(1, 1), a1 + hstep, voffA);
            PG8_WAIT_V(8); PG8_WAIT_L(0); PG8_BAR; PG8_MMA(0, 0, At, B0); PG8_MMA(0, 1, At, B1); PG8_BAR; PG8_SCHED;
            PG8_LDA(At, 0, 1); PG8_STAGE(PG8_SB(0, 0), b2, voffB); PG8_STAGE(PG8_SB(0, 1), b2 + hstep, voffB); PG8_STAGE(PG8_SA(0, 0), a2, voffA);
            PG8_WAIT_V(8); PG8_WAIT_L(0); PG8_BAR; PG8_MMA(1, 0, At, B0); PG8_MMA(1, 1, At, B1); PG8_BAR; PG8_SCHED;
            PG8_LDB(B0, 1, 0); PG8_LDB(B1, 1, 1); PG8_SCHED; PG8_LDA(At, 1, 0); PG8_STAGE(PG8_SA(0, 1), a2 + hstep, voffA);
            PG8_WAIT_V(8); PG8_WAIT_L(0); PG8_BAR; PG8_MMA(0, 0, At, B0); PG8_MMA(0, 1, At, B1); PG8_BAR; PG8_SCHED;
            PG8_LDA(At, 1, 1); PG8_STAGE(PG8_SB(1, 0), b3, voffB); PG8_STAGE(PG8_SB(1, 1), b3 + hstep, voffB); PG8_STAGE(PG8_SA(1, 0), a3, voffA);
            PG8_WAIT_V(8); PG8_WAIT_L(0); PG8_BAR; PG8_MMA(1, 0, At, B0); PG8_MMA(1, 1, At, B1); PG8_BAR; PG8_SCHED;
        }
        if constexpr (ALIGN_EPI) { if (wr == 0) PG8_BAR; }
        E(acc, cur, wr, wc, fr, fq);
        if (!has_next) break;
#pragma unroll
        for (int a = 0; a < 2; ++a)
#pragma unroll
            for (int b = 0; b < 2; ++b)
#pragma unroll
                for (int m = 0; m < 4; ++m)
#pragma unroll
                    for (int n = 0; n < 2; ++n) acc[a][b][m][n] = (f32x4){0.f, 0.f, 0.f, 0.f};
        cur = nxt; cA = nA; cB = nB; ++ui;
        if constexpr (ALIGN_EPI) { if (wr == 1) PG8_BAR; }
    }
    PG8_WAIT_V(0);
    if constexpr (!ALIGN_EPI) { if (wr == 0) PG8_BAR; }
    PG8_BAR;
#undef PG8_SA
#undef PG8_SB
#undef PG8_STAGE
#undef PG8_LDA
#undef PG8_LDB
#undef PG8_MMA
#undef PG8_WAIT_V
#undef PG8_WAIT_L
#undef PG8_BAR
#undef PG8_SCHED
}
}
using pg8::cvt_pk_bf16;

__device__ __forceinline__ float bf_lo(unsigned w) { return __uint_as_float(w << 16); }
__device__ __forceinline__ float bf_hi(unsigned w) { return __uint_as_float(w & 0xffff0000u); }
__device__ __forceinline__ float wave_sum(float v) {
#pragma unroll
    for (int o = 1; o < 64; o <<= 1) v += __shfl_xor(v, o);
    return v;
}
#define LDS_WAIT() asm volatile("s_waitcnt lgkmcnt(0)" ::: "memory")

struct Args { const float* in[23]; float* out; unsigned char* ws; int lo, hi; };

struct P0Item { const float* W; const float* gain; bf16_t* WT; int K, N, k0, n0; };
__device__ __forceinline__ P0Item p0_decode(const Args& a, unsigned char* ws, int it) {
    P0Item d; d.gain = nullptr; int r = it;
    if (r < 2560)        { const int j = r / 1280; r -= j * 1280; d.W = a.in[4] + (size_t)j * D * 2 * DR; d.gain = a.in[1] + (size_t)(3 * j) * D; d.WT = (bf16_t*)(ws + W_AWIN) + (size_t)j * D * 2 * DR; d.K = D; d.N = 2 * DR; }
    else if (r < 3840)   { r -= 2560; const int j = r / 640; r -= j * 640; d.W = a.in[12] + (size_t)j * DR * D; d.WT = (bf16_t*)(ws + W_AWOUT) + (size_t)j * DR * D; d.K = DR; d.N = D; }
    else if (r < 4864)   { r -= 3840; d.W = a.in[13]; d.gain = a.in[1] + 1 * D; d.WT = (bf16_t*)(ws + W_BWIN); d.K = D; d.N = 2 * D; }
    else if (r < 5376)   { r -= 4864; d.W = a.in[17]; d.WT = (bf16_t*)(ws + W_BWOUT); d.K = D; d.N = D; }
    else if (r < 6912)   { r -= 5376; d.W = a.in[18]; d.gain = a.in[1] + 2 * D; d.WT = (bf16_t*)(ws + W_CWIN); d.K = D; d.N = 3 * D; }
    else if (r < 7424)   { r -= 6912; d.W = a.in[20]; d.WT = (bf16_t*)(ws + W_CWOUT); d.K = D; d.N = D; }
    else if (r < 15616)  { r -= 7424; const int i = r >> 11; r &= 2047; d.W = a.in[21] + (size_t)i * D * FF; d.gain = a.in[2] + (size_t)i * D; d.WT = (bf16_t*)(ws + W_W1) + (size_t)i * D * FF; d.K = D; d.N = FF; }
    else                 { r -= 15616; const int i = r >> 11; r &= 2047; d.W = a.in[22] + (size_t)i * FF * D; d.WT = (bf16_t*)(ws + W_W2) + (size_t)i * FF * D; d.K = FF; d.N = D; }
    const int nblk = d.N / 32; d.k0 = 64 * (r / nblk); d.n0 = 32 * (r % nblk);
    return d;
}
constexpr int P0_NITEMS = 23808;
__device__ __forceinline__ void p0_load(const P0Item& d, int lane, f32x4 (&R)[8]) {
    const float* p = d.W + (size_t)(d.k0 + (lane >> 3)) * d.N + d.n0 + 4 * (lane & 7);
#pragma unroll
    for (int i = 0; i < 8; ++i) R[i] = __builtin_nontemporal_load((const f32x4*)(p + (size_t)(8 * i) * d.N));
}
__device__ __forceinline__ void p0_store(const P0Item& d, int lane, const f32x4 (&R)[8], LAS float* scr) {
#pragma unroll
    for (int i = 0; i < 8; ++i) { const int kk = 8 * i + (lane >> 3); const float gk = d.gain ? d.gain[d.k0 + kk] : 1.0f; LAS float* s = scr + kk * 33 + 4 * (lane & 7);
        s[0] = R[i][0] * gk; s[1] = R[i][1] * gk; s[2] = R[i][2] * gk; s[3] = R[i][3] * gk; }
    LDS_WAIT(); asm volatile("" ::: "memory");
    const int c = lane & 7;
#pragma unroll
    for (int j = 0; j < 4; ++j) { const int n = (lane >> 3) + 8 * j; const LAS float* s = scr + (8 * c) * 33 + n;
        u32x4 o; o.x = cvt_pk_bf16(s[0 * 33], s[1 * 33]); o.y = cvt_pk_bf16(s[2 * 33], s[3 * 33]); o.z = cvt_pk_bf16(s[4 * 33], s[5 * 33]); o.w = cvt_pk_bf16(s[6 * 33], s[7 * 33]);
        *(u32x4*)(d.WT + (size_t)(d.n0 + n) * d.K + d.k0 + 8 * c) = o; }
    LDS_WAIT(); asm volatile("" ::: "memory");
}

namespace amid {
constexpr int GWS = 104;
constexpr int OFF_GW = 0, OFF_CONST = 160 * GWS * 2  , OFF_CARRY = OFF_CONST + 8 * 80 * 4, OFF_SEG = OFF_CARRY + 16 * 80 * 4, OFF_WAVE = 45056, WAVE_BYTES = 10880;
static_assert(OFF_SEG + 6 * 80 * 2 * 4 <= OFF_WAVE && OFF_WAVE + 8 * WAVE_BYTES <= 131072 + 1024, "amid LDS map");
}
template <bool PASS2>
__device__ __forceinline__ void a_block(LAS unsigned char* lds, int bu, int tid, int lane, int wave, const bf16_t* XR, const bf16_t* G, bf16_t* Y, float* AGG,
                                        const float* conv_w, const float* conv_b, const bf16_t* GW, const float* ga_b, const float* gx_b, const float* lam) {
    using namespace amid;
    const int h = bu & 15, gI = bu >> 4;
    LAS float* CST = (LAS float*)(lds + OFF_CONST);
    LAS float* CAR = (LAS float*)(lds + OFF_CARRY);
    for (int i = tid; i < 160 * 12; i += 512) { const int row = i / 12, ch = i % 12;
        *(LAS u32x4*)(lds + OFF_GW + row * (GWS * 2) + ch * 16) = *(const u32x4*)(GW + ((size_t)(h * 160 + row)) * 96 + ch * 8); }
    if (tid < 80) { const int c = HD * h + tid;
        CST[0 * 80 + tid] = ga_b[c]; CST[1 * 80 + tid] = gx_b[c]; CST[2 * 80 + tid] = -8.0f * log1pf(__expf(-lam[c])) * LOG2E;
        CST[3 * 80 + tid] = conv_w[0 * DR + c]; CST[4 * 80 + tid] = conv_w[1 * DR + c]; CST[5 * 80 + tid] = conv_w[2 * DR + c]; CST[6 * 80 + tid] = conv_w[3 * DR + c]; CST[7 * 80 + tid] = conv_b[c]; }
    if (PASS2) {
        const int cf = 16 * gI, cb0 = cf & ~127, nprev = cf - cb0, Ls = (nprev + 5) / 6;
        LAS float* SEG = (LAS float*)(lds + OFF_SEG);
        if (tid < 480) {
            const int c = tid % 80, sg = tid / 80, st0 = cb0 + sg * Ls, en = (st0 + Ls < cf) ? st0 + Ls : cf;
            f32x2 pv[19];
#pragma unroll
            for (int i = 0; i < 19; ++i) { const int idx = st0 + i; pv[i] = (idx < en) ? *(const f32x2*)(AGG + ((size_t)idx * DR + HD * h + c) * 2) : (f32x2){1.f, 0.f}; }
            float P = 1.f, H = 0.f;
#pragma unroll
            for (int i = 0; i < 19; ++i) { H = pv[i][0] * H + pv[i][1]; P *= pv[i][0]; }
            SEG[(sg * 80 + c) * 2] = P; SEG[(sg * 80 + c) * 2 + 1] = H;
        }
        __syncthreads();
        if (tid < 80) {
            f32x2 pv[16];
#pragma unroll
            for (int i = 0; i < 16; ++i) pv[i] = *(const f32x2*)(AGG + ((size_t)(cf + i) * DR + HD * h + tid) * 2);
            float s = 0.f;
#pragma unroll
            for (int sg = 0; sg < 6; ++sg) s = SEG[(sg * 80 + tid) * 2] * s + SEG[(sg * 80 + tid) * 2 + 1];
#pragma unroll
            for (int i = 0; i < 16; ++i) { CAR[i * 80 + tid] = s; s = pv[i][0] * s + pv[i][1]; }
        }
    }
    __syncthreads();
    LAS unsigned char* Rb = lds + OFF_WAVE + wave * WAVE_BYTES;
    const int m = lane & 15, q = lane >> 4;
    const int tl = 16 * (m >> 2) + (m & 3);
#pragma unroll 1
    for (int it = 0; it < 2; ++it) {
        const int cn = 16 * gI + 8 * it + wave, row0 = cn * 64;
        const bool first = (cn & 127) == 0;
        int ln = lane; asm volatile("" : "+v"(ln));
        u32x4 xr[11];
#pragma unroll
        for (int i = 0; i < 11; ++i) { const int id = ln + 64 * i, r = id / 10, ch = id - r * 10;
            xr[i] = (u32x4){0u, 0u, 0u, 0u};
            if (id < 670 && !(first && r < 3)) xr[i] = *(const u32x4*)(XR + (long)(row0 - 3 + r) * DR + HD * h + 8 * ch); }
#pragma unroll
        for (int i = 0; i < 11; ++i) { const int id = ln + 64 * i, r = id / 10, ch = id - r * 10; if (id < 670) *(LAS u32x4*)(Rb + r * 160 + 16 * (r >> 4) + 16 * ch) = xr[i]; }
        asm volatile("s_waitcnt lgkmcnt(0)" ::: "memory");
        bf16x8 Af[4][3];
#pragma unroll
        for (int ks = 0; ks < 3; ++ks) {
            const int kc0 = 32 * ks + 8 * q; const bool kval = kc0 < HD; const int kcl = kval ? kc0 : 0;
            f32x4 w[4][2], bb[2];
#pragma unroll
            for (int k = 0; k < 4; ++k) { w[k][0] = *(const LAS f32x4*)(CST + (3 + k) * 80 + kcl); w[k][1] = *(const LAS f32x4*)(CST + (3 + k) * 80 + kcl + 4); }
            bb[0] = *(const LAS f32x4*)(CST + 7 * 80 + kcl); bb[1] = *(const LAS f32x4*)(CST + 7 * 80 + kcl + 4);
#pragma unroll
            for (int rt = 0; rt < 4; ++rt) {
                f32x4 a0 = bb[0], a1 = bb[1];
#pragma unroll
                for (int k = 0; k < 4; ++k) {
                    const int ri = tl + 4 * rt + k;
                    const u32x4 xv = *(const LAS u32x4*)(Rb + ri * 160 + 16 * (ri >> 4) + 2 * kcl);
                    a0[0] += w[k][0][0] * bf_lo(xv.x); a0[1] += w[k][0][1] * bf_hi(xv.x); a0[2] += w[k][0][2] * bf_lo(xv.y); a0[3] += w[k][0][3] * bf_hi(xv.y);
                    a1[0] += w[k][1][0] * bf_lo(xv.z); a1[1] += w[k][1][1] * bf_hi(xv.z); a1[2] += w[k][1][2] * bf_lo(xv.w); a1[3] += w[k][1][3] * bf_hi(xv.w);
                }
                u32x4 pk; pk.x = cvt_pk_bf16(a0[0], a0[1]); pk.y = cvt_pk_bf16(a0[2], a0[3]); pk.z = cvt_pk_bf16(a1[0], a1[1]); pk.w = cvt_pk_bf16(a1[2], a1[3]);
                if (!kval) pk = (u32x4){0u, 0u, 0u, 0u};
                Af[rt][ks] = __builtin_bit_cast(bf16x8, pk);
            }
        }
        if (PASS2) {
            u32x4 gr[10];
#pragma unroll
            for (int i = 0; i < 10; ++i) { const int id = ln + 64 * i, r = id / 10, ch = id - r * 10; gr[i] = *(const u32x4*)(G + (size_t)(row0 + r) * DR + HD * h + 8 * ch); }
            asm volatile("s_waitcnt lgkmcnt(0)" ::: "memory");
#pragma unroll
            for (int i = 0; i < 10; ++i) { const int id = ln + 64 * i, r = id / 10, ch = id - r * 10; *(LAS u32x4*)(Rb + r * 160 + 32 * (r >> 4) + 16 * ch) = gr[i]; }
            asm volatile("s_waitcnt lgkmcnt(0)" ::: "memory");
        }
#pragma unroll 1
        for (int nt = 0; nt < 5; ++nt) {
            const int cl = 16 * nt + m;
            bf16x8 Ba[3], Bx[3];
#pragma unroll
            for (int ks = 0; ks < 3; ++ks) {
                Ba[ks] = *(const LAS bf16x8*)(lds + OFF_GW + (cl) * (GWS * 2) + (32 * ks + 8 * q) * 2);
                Bx[ks] = *(const LAS bf16x8*)(lds + OFF_GW + (80 + cl) * (GWS * 2) + (32 * ks + 8 * q) * 2);
            }
            const float ba = CST[0 * 80 + cl], bx = CST[1 * 80 + cl], kc = CST[2 * 80 + cl];
            bf16x8 Iq;
#pragma unroll
            for (int j = 0; j < 8; ++j) Iq[j] = (8 * q + j == 16 * (nt & 1) + m) ? (short)0x3F80 : (short)0;
            f32x4 ar[4], ax[4], ac[4];
#pragma unroll
            for (int rt = 0; rt < 4; ++rt) {
                ar[rt] = (f32x4){0.f, 0.f, 0.f, 0.f}; ax[rt] = ar[rt]; ac[rt] = ar[rt];
#pragma unroll
                for (int ks = 0; ks < 3; ++ks) {
                    ar[rt] = __builtin_amdgcn_mfma_f32_16x16x32_bf16(Af[rt][ks], Ba[ks], ar[rt], 0, 0, 0);
                    ax[rt] = __builtin_amdgcn_mfma_f32_16x16x32_bf16(Af[rt][ks], Bx[ks], ax[rt], 0, 0, 0);
                }
                const bf16x8 Asel = (nt < 2) ? Af[rt][0] : ((nt < 4) ? Af[rt][1] : Af[rt][2]);
                ac[rt] = __builtin_amdgcn_mfma_f32_16x16x32_bf16(Asel, Iq, ac[rt], 0, 0, 0);
            }
            float hl = 0.f, ca = 1.f; float hs[16], cs[16];
#pragma unroll
            for (int rt = 0; rt < 4; ++rt)
#pragma unroll
                for (int i = 0; i < 4; ++i) {
                    const float r = pg8::sigmoidf_(ar[rt][i] + ba), ig = pg8::sigmoidf_(ax[rt][i] + bx);
                    const float a = pg8::fast_exp2(r * kc);
                    const float mult = __builtin_amdgcn_sqrtf(fmaxf(1.0f - a * a, 0.f));
                    const float uu = mult * ig * ac[rt][i];
                    hl = a * hl + uu; ca *= a;
                    if (PASS2) { hs[4 * rt + i] = hl; cs[4 * rt + i] = ca; }
                }
            const float A0 = __shfl(ca, m), H0 = __shfl(hl, m), A1 = __shfl(ca, m + 16), H1 = __shfl(hl, m + 16), A2 = __shfl(ca, m + 32), H2 = __shfl(hl, m + 32);
            if (!PASS2) {
                const float A3 = __shfl(ca, m + 48), H3 = __shfl(hl, m + 48);
                float s = H0; s = A1 * s + H1; s = A2 * s + H2; s = A3 * s + H3;
                const float P = (A0 * A1) * (A2 * A3);
                if (q == 0) *(f32x2*)(AGG + ((size_t)cn * DR + HD * h + cl) * 2) = (f32x2){P, s};
            } else {
                const float s0 = CAR[(8 * it + wave) * 80 + cl];
                const float s1 = A0 * s0 + H0, s2 = A1 * s1 + H1, s3 = A2 * s2 + H2;
                const float sq = q == 0 ? s0 : (q == 1 ? s1 : (q == 2 ? s2 : s3));
                LAS bf16_t* gy = (LAS bf16_t*)(Rb + (16 * q) * 160 + 32 * q + 2 * cl);
#pragma unroll
                for (int st = 0; st < 16; ++st) {
                    const float hv = hs[st] + cs[st] * sq;
                    const float gv = __uint_as_float((unsigned)gy[st * 80] << 16);
                    gy[st * 80] = (bf16_t)(cvt_pk_bf16(hv * gv, 0.f) & 0xffffu);
                }
            }
        }
        if (PASS2) {
            asm volatile("s_waitcnt lgkmcnt(0)" ::: "memory");
#pragma unroll
            for (int i = 0; i < 10; ++i) { const int id = ln + 64 * i, r = id / 10, ch = id - r * 10;
                const u32x4 v = *(const LAS u32x4*)(Rb + r * 160 + 32 * (r >> 4) + 16 * ch);
                *(u32x4*)(Y + (size_t)(row0 + r) * DR + HD * h + 8 * ch) = v; }
            asm volatile("s_waitcnt lgkmcnt(0)" ::: "memory");
        }
    }
    __syncthreads();
}

constexpr int LDV = 136;
__device__ __forceinline__ void sgu_unit(LAS unsigned char* lds, int u, int tid, int lane, int wave, const bf16_t* U, const bf16_t* V, bf16_t* Y,
                                         const float* ssv, const float* ng, const bf16_t* WSb, const float* sbias) {
    const int g = u & 7, cn = u >> 3, row0 = cn * 128;
    LAS bf16_t* vt = (LAS bf16_t*)lds;
    {
        const int c0 = 8 * (tid & 15);
        const f32x4 g0 = *(const f32x4*)(ng + g * 128 + c0), g1 = *(const f32x4*)(ng + g * 128 + c0 + 4);
#pragma unroll
        for (int i = 0; i < 2; ++i) {
            const int s = 2 * ((tid >> 4) + 32 * i);
            const u32x4 va = *(const u32x4*)(V + (size_t)(row0 + s) * D + g * 128 + c0), vb = *(const u32x4*)(V + (size_t)(row0 + s + 1) * D + g * 128 + c0);
            float sa = 0.f, sb = 0.f;
#pragma unroll
            for (int k = 0; k < 4; ++k) { const f32x4 pa = *(const f32x4*)(ssv + (size_t)(row0 + s) * 16 + 4 * k), pb = *(const f32x4*)(ssv + (size_t)(row0 + s + 1) * 16 + 4 * k);
                sa += (pa[0] + pa[1]) + (pa[2] + pa[3]); sb += (pb[0] + pb[1]) + (pb[2] + pb[3]); }
            const float ra = __builtin_amdgcn_rsqf(sa * (1.0f / 1024.0f) + EPS), rb = __builtin_amdgcn_rsqf(sb * (1.0f / 1024.0f) + EPS);
            LAS unsigned* dst = (LAS unsigned*)(vt + s);
            dst[(c0 + 0) * (LDV / 2)] = cvt_pk_bf16(bf_lo(va.x) * ra * g0[0], bf_lo(vb.x) * rb * g0[0]);
            dst[(c0 + 1) * (LDV / 2)] = cvt_pk_bf16(bf_hi(va.x) * ra * g0[1], bf_hi(vb.x) * rb * g0[1]);
            dst[(c0 + 2) * (LDV / 2)] = cvt_pk_bf16(bf_lo(va.y) * ra * g0[2], bf_lo(vb.y) * rb * g0[2]);
            dst[(c0 + 3) * (LDV / 2)] = cvt_pk_bf16(bf_hi(va.y) * ra * g0[3], bf_hi(vb.y) * rb * g0[3]);
            dst[(c0 + 4) * (LDV / 2)] = cvt_pk_bf16(bf_lo(va.z) * ra * g1[0], bf_lo(vb.z) * rb * g1[0]);
            dst[(c0 + 5) * (LDV / 2)] = cvt_pk_bf16(bf_hi(va.z) * ra * g1[1], bf_hi(vb.z) * rb * g1[1]);
            dst[(c0 + 6) * (LDV / 2)] = cvt_pk_bf16(bf_lo(va.w) * ra * g1[2], bf_lo(vb.w) * rb * g1[2]);
            dst[(c0 + 7) * (LDV / 2)] = cvt_pk_bf16(bf_hi(va.w) * ra * g1[3], bf_hi(vb.w) * rb * g1[3]);
        }
    }
    __syncthreads();
    {
        const int m = lane & 15, q = lane >> 4, t = 16 * wave + m, kmax = wave >> 1;
        bf16x8 Bw[4];
#pragma unroll
        for (int ks = 0; ks < 4; ++ks) { Bw[ks] = (bf16x8){0, 0, 0, 0, 0, 0, 0, 0}; if (ks <= kmax) Bw[ks] = *(const bf16x8*)(WSb + ((size_t)(g * 128 + t)) * 128 + 32 * ks + 8 * q); }
        const float bias = sbias[g * 128 + t];
#pragma unroll
        for (int p = 0; p < 4; ++p) {
            f32x4 ac[2];
#pragma unroll
            for (int e = 0; e < 2; ++e) {
                ac[e] = (f32x4){0.f, 0.f, 0.f, 0.f};
                const int cc = 32 * p + 8 * (m >> 2) + 4 * e + (m & 3);
#pragma unroll
                for (int ks = 0; ks < 4; ++ks) if (ks <= kmax) {
                    const bf16x8 Afr = *(const LAS bf16x8*)(vt + cc * LDV + 32 * ks + 8 * q);
                    ac[e] = __builtin_amdgcn_mfma_f32_16x16x32_bf16(Afr, Bw[ks], ac[e], 0, 0, 0);
                }
            }
            const size_t off = (size_t)(row0 + t) * D + g * 128 + 32 * p + 8 * q;
            const u32x4 uv = *(const u32x4*)(U + off);
            u32x4 o;
            o.x = cvt_pk_bf16(bf_lo(uv.x) * (ac[0][0] + bias), bf_hi(uv.x) * (ac[0][1] + bias));
            o.y = cvt_pk_bf16(bf_lo(uv.y) * (ac[0][2] + bias), bf_hi(uv.y) * (ac[0][3] + bias));
            o.z = cvt_pk_bf16(bf_lo(uv.z) * (ac[1][0] + bias), bf_hi(uv.z) * (ac[1][1] + bias));
            o.w = cvt_pk_bf16(bf_lo(uv.w) * (ac[1][2] + bias), bf_hi(uv.w) * (ac[1][3] + bias));
            *(u32x4*)(Y + off) = o;
        }
    }
    __syncthreads();
}


#define XB_TMO      128
#define XB_XCNT(j)  (256  + 64 * (j))
#define XB_XSUB(j)  (1280 + 64 * (j))
#define XB_XGEN(j)  (2304 + 64 * (j))
#define XB_TOP      3328
#define XB_TOPGEN   3392
#define XCD_BAR_WORDS 3456
#define XB_SPIN_CAP (1u << 18)
__device__ __forceinline__ unsigned xb_ld(unsigned* p)              { return __hip_atomic_load(p, __ATOMIC_RELAXED, __HIP_MEMORY_SCOPE_AGENT); }
__device__ __forceinline__ unsigned xb_add(unsigned* p, unsigned v) { return __hip_atomic_fetch_add(p, v, __ATOMIC_RELAXED, __HIP_MEMORY_SCOPE_AGENT); }
__device__ __forceinline__ unsigned xb_xcc_id() { return (unsigned)__builtin_amdgcn_s_getreg((3 << 11) | 20) & 0xFu; }
#define XB_SPIN(cond, bar) do { unsigned _sp = 0; while (cond) { __builtin_amdgcn_s_sleep(1); \
    if ((++_sp & 255u) == 0u) { if (xb_ld(&(bar)[XB_TMO])) break; if (_sp > XB_SPIN_CAP) { atomicAdd(&(bar)[XB_TMO], 1u); break; } } } } while (0)
struct XcdBarrier { unsigned* bar; unsigned x; volatile LAS unsigned* st; };
__device__ __forceinline__ XcdBarrier xcd_barrier_post(unsigned* bar, volatile LAS unsigned* st) {
    XcdBarrier b; b.bar = bar; b.x = xb_xcc_id(); b.st = st;
    if (threadIdx.x == 0) (void)xb_add(&bar[XB_XCNT(b.x)], 1u);
    return b;
}
__device__ __forceinline__ void xcd_barrier_complete(unsigned* bar, unsigned x, unsigned& nloc, unsigned& nx) {
    const unsigned G = gridDim.x * gridDim.y * gridDim.z;
    unsigned sum, cnt, mine, sp = 0u;
    for (;;) {
        sum = 0u; cnt = 0u; mine = 0u;
#pragma unroll
        for (unsigned j = 0; j < 16; ++j) { const unsigned c = xb_ld(&bar[XB_XCNT(j)]); sum += c; cnt += (c > 0u) ? 1u : 0u; mine = (j == x) ? c : mine; }
        if (sum == G) break;
        __builtin_amdgcn_s_sleep(1);
        if ((++sp & 255u) == 0u) { if (xb_ld(&bar[XB_TMO])) break; if (sp > XB_SPIN_CAP) { atomicAdd(&bar[XB_TMO], 1u); break; } }
    }
    nloc = mine > 0u ? mine : 1u; nx = cnt > 0u ? cnt : 1u;
}
__device__ __forceinline__ void xcd_barrier(const XcdBarrier& b) {
    asm volatile("s_waitcnt vmcnt(0)" ::: "memory");
    __syncthreads();
    if (threadIdx.x == 0) {
        unsigned* bar = b.bar;
        __builtin_amdgcn_s_waitcnt(0);
        unsigned nloc = b.st[0], nx = b.st[1];
        if (nloc == 0u) { xcd_barrier_complete(bar, b.x, nloc, nx); b.st[0] = nloc; b.st[1] = nx; }
        const unsigned old = xb_add(&bar[XB_XSUB(b.x)], 1u);
        const unsigned gen = old / nloc;
        if (old + 1u == (gen + 1u) * nloc) {
            __builtin_amdgcn_fence(__ATOMIC_RELEASE, "agent");
            asm volatile("s_waitcnt vmcnt(0)" ::: "memory");
            const unsigned og = xb_add(&bar[XB_TOP], 1u);
            const unsigned tg = og / nx;
            if (og + 1u == (tg + 1u) * nx) xb_add(&bar[XB_TOPGEN], 1u);
            else XB_SPIN(xb_ld(&bar[XB_TOPGEN]) == tg, bar);
            __builtin_amdgcn_fence(__ATOMIC_ACQUIRE, "agent");
            xb_add(&bar[XB_XGEN(b.x)], 1u);
            asm volatile("s_waitcnt vmcnt(0)" ::: "memory");
        } else {
            XB_SPIN(xb_ld(&bar[XB_XGEN(b.x)]) == gen, bar);
            __builtin_amdgcn_fence(__ATOMIC_ACQUIRE, "agent");
            asm volatile("s_waitcnt vmcnt(0)" ::: "memory");
        }
    }
    __syncthreads();
}

__global__ void __launch_bounds__(512, 2) trunk_fwd(Args args) {
    extern __shared__ __attribute__((aligned(16))) unsigned char lds_raw[];
    LAS unsigned char* lds = (LAS unsigned char*)lds_raw;
    const int G_ = gridDim.x, bx = blockIdx.x;
    const int NGW = G_ * 8, NGT = G_ * 512;
#define PHASE_IDS() int tid = threadIdx.x; asm volatile("" : "+v"(tid)); const int lane = tid & 63, wave = __builtin_amdgcn_readfirstlane(tid >> 6), gw = bx * 8 + wave, gtid = bx * 512 + tid; (void)lane; (void)wave; (void)gw; (void)gtid
    unsigned char* ws = args.ws;
    float* X = args.out;
    float* SSP = (float*)(ws + WS_SSP);
    bf16_t* XB = (bf16_t*)(ws + WS_XB);
    unsigned char* BIG = ws + WS_BIG;
    const int lo = args.lo, hi = args.hi;
    int ph = 0;
#define RUN() (ph >= lo && ph < hi)
    volatile LAS unsigned* bst = (volatile LAS unsigned*)(lds + 135168);
    if (threadIdx.x < 2) bst[threadIdx.x] = 0u;
    __syncthreads();
    XcdBarrier xbar; xbar.bar = (unsigned*)(ws + WS_BAR); xbar.x = 0; xbar.st = bst;
#define SEAM() do { ++ph; if (ph > lo && ph < hi) { if (ph == 1) { cg::this_grid().sync(); xbar = xcd_barrier_post((unsigned*)(ws + WS_BAR), bst); } else xcd_barrier(xbar); } } while (0)

    _Pragma("unroll 1") for (int rep_ = 0; rep_ < (RUN() ? REP_0 : 0); ++rep_) { PHASE_IDS();
        if (bx == 0) for (int i = tid; i < XCD_BAR_WORDS; i += 512) ((unsigned*)(ws + WS_BAR))[i] = 0u;
        LAS float* scr = (LAS float*)(lds + wave * 16384);
        {
            f32x4 R0[8], R1[8];
            int it = gw;
            if (it < P0_NITEMS) { const P0Item d = p0_decode(args, ws, it); p0_load(d, lane, R0); }
#pragma unroll 1
            for (; it < P0_NITEMS; it += 2 * NGW) {
                const int it1 = it + NGW, it2 = it + 2 * NGW;
                if (it1 < P0_NITEMS) { const P0Item d1 = p0_decode(args, ws, it1); p0_load(d1, lane, R1); }
                { const P0Item d = p0_decode(args, ws, it); p0_store(d, lane, R0, scr); }
                if (it2 < P0_NITEMS) { const P0Item d2 = p0_decode(args, ws, it2); p0_load(d2, lane, R0); }
                if (it1 < P0_NITEMS) { const P0Item d1 = p0_decode(args, ws, it1); p0_store(d1, lane, R1, scr); }
            }
        }
        for (int id = gtid; id < 2 * NH * 2 * HD * 12; id += NGT) {
            const int k8 = id % 12, n = (id / 12) % HD, qq = (id / (12 * HD)) & 1, jh = id / (12 * HD * 2);
            const float* Wg = (qq ? args.in[9] : args.in[7]) + (size_t)jh * HD * HD;
            float v[8];
#pragma unroll
            for (int j = 0; j < 8; ++j) { const int k = 8 * k8 + j; v[j] = (k < HD) ? Wg[k * HD + n] : 0.f; }
            u32x4 o; o.x = cvt_pk_bf16(v[0], v[1]); o.y = cvt_pk_bf16(v[2], v[3]); o.z = cvt_pk_bf16(v[4], v[5]); o.w = cvt_pk_bf16(v[6], v[7]);
            *(u32x4*)((bf16_t*)(ws + WS_GW) + (size_t)id * 8) = o;
        }
        for (int id = gtid; id < 8 * 128 * 16; id += NGT) {
            const int s8 = id & 15, t = (id >> 4) & 127;
            const float* p = args.in[15] + (size_t)id * 8; float v[8];
#pragma unroll
            for (int j = 0; j < 8; ++j) v[j] = (8 * s8 + j <= t) ? p[j] : 0.f;
            u32x4 o; o.x = cvt_pk_bf16(v[0], v[1]); o.y = cvt_pk_bf16(v[2], v[3]); o.z = cvt_pk_bf16(v[4], v[5]); o.w = cvt_pk_bf16(v[6], v[7]);
            *(u32x4*)((bf16_t*)(ws + WS_WSB) + (size_t)id * 8) = o;
        }
        const float* x = args.in[0];
        for (int r = gw; r < M; r += 2 * NGW) {
            const int r1 = r + NGW;
            f32x4 va[4], vb[4];
#pragma unroll
            for (int j = 0; j < 4; ++j) { va[j] = __builtin_nontemporal_load((const f32x4*)(x + (size_t)r * D) + lane + 64 * j); vb[j] = (r1 < M) ? __builtin_nontemporal_load((const f32x4*)(x + (size_t)r1 * D) + lane + 64 * j) : (f32x4){0.f, 0.f, 0.f, 0.f}; }
            float sa = 0.f, sb = 0.f;
            unsigned long long* oa = (unsigned long long*)(XB + (size_t)r * D) + lane; unsigned long long* ob = (unsigned long long*)(XB + (size_t)r1 * D) + lane;
#pragma unroll
            for (int j = 0; j < 4; ++j) {
                sa += (va[j][0] * va[j][0] + va[j][1] * va[j][1]) + (va[j][2] * va[j][2] + va[j][3] * va[j][3]);
                sb += (vb[j][0] * vb[j][0] + vb[j][1] * vb[j][1]) + (vb[j][2] * vb[j][2] + vb[j][3] * vb[j][3]);
                oa[64 * j] = (unsigned long long)cvt_pk_bf16(va[j][0], va[j][1]) | ((unsigned long long)cvt_pk_bf16(va[j][2], va[j][3]) << 32);
                if (r1 < M) ob[64 * j] = (unsigned long long)cvt_pk_bf16(vb[j][0], vb[j][1]) | ((unsigned long long)cvt_pk_bf16(vb[j][2], vb[j][3]) << 32);
            }
            sa = wave_sum(sa); sb = wave_sum(sb);
            if (lane < 16) { SSP[(size_t)r * 16 + lane] = (lane == 0) ? sa : 0.f; if (r1 < M) SSP[(size_t)r1 * 16 + lane] = (lane == 0) ? sb : 0.f; }
        }
    }
    SEAM();

#pragma unroll 1
    for (int L = 0; L < 4; ++L) {
        const int kind = L % 3, j = L / 3;
        const float* xbase = (L == 0) ? args.in[0] : X;
        const bf16_t* Ymix; const bf16_t* Wout; int Kout;
        if (kind == 0) {
            bf16_t* Gb = (bf16_t*)(BIG + A_G); bf16_t* XRb = (bf16_t*)(BIG + A_XR); bf16_t* Yb = (bf16_t*)(BIG + A_Y);
            float* AGG = (float*)(BIG + A_AGG);
            _Pragma("unroll 1") for (int rep_ = 0; rep_ < (RUN() ? REP_1 : 0); ++rep_) { PHASE_IDS();
                pg8::Gemm g{XB, (const bf16_t*)(ws + W_AWIN) + (size_t)j * D * 2 * DR, M, 2 * DR, D}; pg8::StaticOrder S; S.init(M, 2 * DR, G_, bx);
                pg8::EpiAct<0> E{Gb, DR, DR, (size_t)(A_XR - A_G) / 2, SSP, nullptr};
                pg8::gemm_phase<pg8::EpiAct<0>, pg8::StaticOrder>(lds, g, S, E);
            }
            SEAM();
            const float* cw = args.in[5] + (size_t)j * 4 * DR; const float* cb = args.in[6] + (size_t)j * DR;
            const bf16_t* GWl = (const bf16_t*)(ws + WS_GW) + (size_t)j * NH * 2 * HD * 96;
            const float* gab = args.in[8] + (size_t)j * DR; const float* gxb = args.in[10] + (size_t)j * DR; const float* lam = args.in[11] + (size_t)j * DR;
            _Pragma("unroll 1") for (int rep_ = 0; rep_ < (RUN() ? REP_2 : 0); ++rep_) { PHASE_IDS();
#pragma unroll 1
                for (int bu = bx; bu < 256; bu += G_) a_block<false>(lds, bu, tid, lane, wave, XRb, Gb, Yb, AGG, cw, cb, GWl, gab, gxb, lam);
            }
            SEAM();
            _Pragma("unroll 1") for (int rep_ = 0; rep_ < (RUN() ? REP_4 : 0); ++rep_) { PHASE_IDS();
#pragma unroll 1
                for (int bu = bx; bu < 256; bu += G_) a_block<true>(lds, bu, tid, lane, wave, XRb, Gb, Yb, AGG, cw, cb, GWl, gab, gxb, lam);
            }
            SEAM();
            Ymix = Yb; Wout = (const bf16_t*)(ws + W_AWOUT) + (size_t)j * DR * D; Kout = DR;
        } else if (kind == 1) {
            bf16_t* Ub = (bf16_t*)(BIG + B_U); bf16_t* Vb = (bf16_t*)(BIG + B_V); bf16_t* Yb = (bf16_t*)(BIG + B_Y); float* SSV = (float*)(BIG + B_SSV);
            _Pragma("unroll 1") for (int rep_ = 0; rep_ < (RUN() ? REP_5 : 0); ++rep_) { PHASE_IDS();
                pg8::Gemm g{XB, (const bf16_t*)(ws + W_BWIN), M, 2 * D, D}; pg8::StaticOrder S; S.init(M, 2 * D, G_, bx);
                pg8::EpiAct<2> E{Ub, D, D, (size_t)(B_V - B_U) / 2, SSP, SSV};
                pg8::gemm_phase<pg8::EpiAct<2>, pg8::StaticOrder>(lds, g, S, E);
            }
            SEAM();
            _Pragma("unroll 1") for (int rep_ = 0; rep_ < (RUN() ? REP_6 : 0); ++rep_) { PHASE_IDS();
#pragma unroll 1
                for (int u = bx; u < 128 * 8; u += G_) sgu_unit(lds, u, tid, lane, wave, Ub, Vb, Yb, SSV, args.in[14], (const bf16_t*)(ws + WS_WSB), args.in[16]);
            }
            SEAM();
            Ymix = Yb; Wout = (const bf16_t*)(ws + W_BWOUT); Kout = D;
        } else {
            bf16_t* GCX = (bf16_t*)(BIG + C_GCX); bf16_t* Yb = (bf16_t*)(BIG + C_Y);
            _Pragma("unroll 1") for (int rep_ = 0; rep_ < (RUN() ? REP_7 : 0); ++rep_) { PHASE_IDS();
                pg8::Gemm g{XB, (const bf16_t*)(ws + W_CWIN), M, 3 * D, D}; pg8::StaticOrder S; S.init(M, 3 * D, G_, bx);
                pg8::EpiAct<3> E{GCX, 3 * D, 0, 0, SSP, nullptr};
                pg8::gemm_phase<pg8::EpiAct<3>, pg8::StaticOrder>(lds, g, S, E);
            }
            SEAM();
            _Pragma("unroll 1") for (int rep_ = 0; rep_ < (RUN() ? REP_8 : 0); ++rep_) { PHASE_IDS();
                const float* cw = args.in[19];
                for (int id = gtid; id < (M / 16) * 128; id += NGT) {
                    const int cgp = id & 127, r = id >> 7, c0 = 8 * cgp, rowb = r * 16;
                    f32x4 w[3][2];
#pragma unroll
                    for (int k = 0; k < 3; ++k) { w[k][0] = *(const f32x4*)(cw + k * D + c0); w[k][1] = *(const f32x4*)(cw + k * D + c0 + 4); }
                    float p2[8], p1[8];
#pragma unroll
                    for (int jj = 0; jj < 8; ++jj) { p2[jj] = 0.f; p1[jj] = 0.f; }
                    if ((rowb & (SEQ - 1)) != 0) {
                        const u32x4 ga = *(const u32x4*)(GCX + (size_t)(rowb - 2) * 3 * D + D + c0), xa = *(const u32x4*)(GCX + (size_t)(rowb - 2) * 3 * D + 2 * D + c0);
                        const u32x4 gb_ = *(const u32x4*)(GCX + (size_t)(rowb - 1) * 3 * D + D + c0), xb_ = *(const u32x4*)(GCX + (size_t)(rowb - 1) * 3 * D + 2 * D + c0);
                        p2[0] = bf_lo(ga.x) * bf_lo(xa.x); p2[1] = bf_hi(ga.x) * bf_hi(xa.x); p2[2] = bf_lo(ga.y) * bf_lo(xa.y); p2[3] = bf_hi(ga.y) * bf_hi(xa.y);
                        p2[4] = bf_lo(ga.z) * bf_lo(xa.z); p2[5] = bf_hi(ga.z) * bf_hi(xa.z); p2[6] = bf_lo(ga.w) * bf_lo(xa.w); p2[7] = bf_hi(ga.w) * bf_hi(xa.w);
                        p1[0] = bf_lo(gb_.x) * bf_lo(xb_.x); p1[1] = bf_hi(gb_.x) * bf_hi(xb_.x); p1[2] = bf_lo(gb_.y) * bf_lo(xb_.y); p1[3] = bf_hi(gb_.y) * bf_hi(xb_.y);
                        p1[4] = bf_lo(gb_.z) * bf_lo(xb_.z); p1[5] = bf_hi(gb_.z) * bf_hi(xb_.z); p1[6] = bf_lo(gb_.w) * bf_lo(xb_.w); p1[7] = bf_hi(gb_.w) * bf_hi(xb_.w);
                    }
#pragma unroll 4
                    for (int t = 0; t < 16; ++t) {
                        const size_t ro = (size_t)(rowb + t) * 3 * D + c0;
                        const u32x4 bb = *(const u32x4*)(GCX + ro), gc = *(const u32x4*)(GCX + ro + D), xv = *(const u32x4*)(GCX + ro + 2 * D);
                        float p0[8], gbv[8];
                        p0[0] = bf_lo(gc.x) * bf_lo(xv.x); p0[1] = bf_hi(gc.x) * bf_hi(xv.x); p0[2] = bf_lo(gc.y) * bf_lo(xv.y); p0[3] = bf_hi(gc.y) * bf_hi(xv.y);
                        p0[4] = bf_lo(gc.z) * bf_lo(xv.z); p0[5] = bf_hi(gc.z) * bf_hi(xv.z); p0[6] = bf_lo(gc.w) * bf_lo(xv.w); p0[7] = bf_hi(gc.w) * bf_hi(xv.w);
                        gbv[0] = bf_lo(bb.x); gbv[1] = bf_hi(bb.x); gbv[2] = bf_lo(bb.y); gbv[3] = bf_hi(bb.y); gbv[4] = bf_lo(bb.z); gbv[5] = bf_hi(bb.z); gbv[6] = bf_lo(bb.w); gbv[7] = bf_hi(bb.w);
                        float y[8];
#pragma unroll
                        for (int jj = 0; jj < 8; ++jj) { y[jj] = gbv[jj] * (w[0][jj >> 2][jj & 3] * p2[jj] + w[1][jj >> 2][jj & 3] * p1[jj] + w[2][jj >> 2][jj & 3] * p0[jj]); p2[jj] = p1[jj]; p1[jj] = p0[jj]; }
                        u32x4 o; o.x = cvt_pk_bf16(y[0], y[1]); o.y = cvt_pk_bf16(y[2], y[3]); o.z = cvt_pk_bf16(y[4], y[5]); o.w = cvt_pk_bf16(y[6], y[7]);
                        *(u32x4*)(Yb + (size_t)(rowb + t) * D + c0) = o;
                    }
                }
            }
            SEAM();
            Ymix = Yb; Wout = (const bf16_t*)(ws + W_CWOUT); Kout = D;
        }
        _Pragma("unroll 1") for (int rep_ = 0; rep_ < (RUN() ? REP_9 : 0); ++rep_) { PHASE_IDS();
            pg8::Gemm g{Ymix, Wout, M, D, Kout}; pg8::StaticOrder S; S.init(M, D, G_, bx);
            pg8::EpiRes E{xbase, X, XB, SSP};
            pg8::gemm_phase<pg8::EpiRes, pg8::StaticOrder>(lds, g, S, E);
        }
        SEAM();
        _Pragma("unroll 1") for (int rep_ = 0; rep_ < (RUN() ? REP_10 : 0); ++rep_) { PHASE_IDS();
            pg8::Gemm g{XB, (const bf16_t*)(ws + W_W1) + (size_t)L * D * FF, M, FF, D}; pg8::StaticOrder S; S.init(M, FF, G_, bx);
            pg8::EpiAct<1> E{(bf16_t*)BIG, FF, 0, 0, SSP, nullptr};
            pg8::gemm_phase<pg8::EpiAct<1>, pg8::StaticOrder>(lds, g, S, E);
        }
        SEAM();
        _Pragma("unroll 1") for (int rep_ = 0; rep_ < (RUN() ? REP_11 : 0); ++rep_) { PHASE_IDS();
            pg8::Gemm g{(const bf16_t*)BIG, (const bf16_t*)(ws + W_W2) + (size_t)L * FF * D, M, D, FF}; pg8::StaticOrder S; S.init(M, D, G_, bx);
            pg8::EpiRes E{X, X, XB, SSP};
            pg8::gemm_phase<pg8::EpiRes, pg8::StaticOrder>(lds, g, S, E);
        }
        SEAM();
    }
    _Pragma("unroll 1") for (int rep_ = 0; rep_ < (RUN() ? REP_12 : 0); ++rep_) { PHASE_IDS();
        const float* fg = args.in[3];
        for (int r = gw; r < M; r += NGW) {
            float s = (lane < 16) ? SSP[(size_t)r * 16 + lane] : 0.f;
            s = wave_sum(s);
            const float rs = __builtin_amdgcn_rsqf(s * (1.0f / 1024.0f) + EPS);
            f32x4* xr = (f32x4*)(X + (size_t)r * D) + lane; const f32x4* gr = (const f32x4*)fg + lane;
#pragma unroll
            for (int jj = 0; jj < 4; ++jj) { const f32x4 v = xr[64 * jj], gg = gr[64 * jj]; xr[64 * jj] = v * rs * gg; }
        }
    }
#undef RUN
#undef SEAM
}

extern "C" void kernel_launch(void* const* d_in, const int* in_sizes, int n_in, void* d_out, int out_size, void* d_ws, size_t ws_size, hipStream_t stream) {
    static int grid = 0;
    if (grid == 0) {
        if (n_in != 23 || in_sizes[0] != M * D || out_size != M * D || ws_size < WS_END) {
            fprintf(stderr, "kernel_launch: unexpected shapes (n_in %d, in0 %d, out %d, ws %zu < %zu); nothing launched\n", n_in, n_in > 0 ? in_sizes[0] : -1, out_size, ws_size, (size_t)WS_END); grid = -1; return; }
        int dev = 0, cus = 0, per_cu = 0;
        if (hipGetDevice(&dev) != hipSuccess || hipDeviceGetAttribute(&cus, hipDeviceAttributeMultiprocessorCount, dev) != hipSuccess) { grid = -1; return; }
        if (hipFuncSetAttribute((const void*)trunk_fwd, hipFuncAttributeMaxDynamicSharedMemorySize, LDS_BYTES) != hipSuccess) { fprintf(stderr, "kernel_launch: hipFuncSetAttribute failed\n"); grid = -1; return; }
        if (hipOccupancyMaxActiveBlocksPerMultiprocessor(&per_cu, (const void*)trunk_fwd, 512, LDS_BYTES) != hipSuccess || per_cu < 1) { fprintf(stderr, "kernel_launch: occupancy query gave %d\n", per_cu); per_cu = 1; }
        (void)hipGetLastError();
        grid = cus * per_cu;
    }
    if (grid < 0) return;
    Args a{};
    for (int i = 0; i < 23; ++i) a.in[i] = (const float*)d_in[i];
    a.out = (float*)d_out; a.ws = (unsigned char*)d_ws;
#if MK_MULTI
    for (int p = 0; p < NPHASE; ++p) { a.lo = p; a.hi = p + 1; hipLaunchKernelGGL(trunk_fwd, dim3(grid), dim3(512), LDS_BYTES, stream, a); }
#else
    a.lo = 0; a.hi = NPHASE;
    void* kargs[] = {(void*)&a};
    hipError_t e = hipLaunchCooperativeKernel((const void*)trunk_fwd, dim3(grid), dim3(512), kargs, LDS_BYTES, stream);
    if (e != hipSuccess) fprintf(stderr, "kernel_launch: cooperative launch failed: %s (grid %d)\n", hipGetErrorString(e), grid);
#endif
}
```

```cpp
#include <hip/hip_runtime.h>
#include <hip/hip_cooperative_groups.h>
#include <cstdio>
#include <cstdint>
namespace cg = cooperative_groups;

#ifndef PHMASK
#define PHMASK 0xFFFFFFFFu
#endif
#ifndef REP_0
#define REP_0 1
#endif
#ifndef REP_1
#define REP_1 1
#endif
#ifndef REP_2
#define REP_2 1
#endif
#ifndef REP_3
#define REP_3 1
#endif
#ifndef REP_4
#define REP_4 1
#endif
#ifndef REP_5
#define REP_5 1
#endif
#ifndef REP_6
#define REP_6 1
#endif
#ifndef REP_7
#define REP_7 1
#endif
#ifndef REP_8
#define REP_8 1
#endif
#ifndef REP_9
#define REP_9 1
#endif
#ifndef REP_10
#define REP_10 1
#endif
#ifndef REP_11
#define REP_11 1
#endif
#ifndef REP_12
#define REP_12 1
#endif
#ifndef MK_MULTI
#define MK_MULTI 0
#endif

#define LAS __attribute__((address_space(3)))
typedef unsigned short bf16_t;
typedef short bf16x8 __attribute__((ext_vector_type(8)));
typedef float f32x4 __attribute__((ext_vector_type(4)));
typedef float f32x2 __attribute__((ext_vector_type(2)));
typedef unsigned u32x4 __attribute__((ext_vector_type(4)));
typedef unsigned u32x2 __attribute__((ext_vector_type(2)));

constexpr int SEQ = 8192, M = 2 * SEQ, D = 1024, DR = 1280, FF = 4096, NH = 16, HD = 80;
constexpr float EPS = 1e-6f, LOG2E = 1.4426950408889634f;
constexpr int NPHASE = 24;

constexpr size_t MiB = 1u << 20;
constexpr size_t WS_SSP = 0;
constexpr size_t WS_GW = 1 * MiB;
constexpr size_t WS_BAR = 1 * MiB + 983040;
constexpr size_t WS_WSB = 2 * MiB;
constexpr size_t WS_W = 2 * MiB + 256 * 1024;
constexpr size_t W_AWIN = WS_W, W_AWOUT = WS_W + 10 * MiB, W_BWIN = WS_W + 15 * MiB, W_BWOUT = WS_W + 19 * MiB, W_CWIN = WS_W + 21 * MiB,
                 W_CWOUT = WS_W + 27 * MiB, W_W1 = WS_W + 29 * MiB, W_W2 = WS_W + 61 * MiB;
constexpr size_t WS_XB = WS_W + 93 * MiB;
constexpr size_t WS_BIG = WS_XB + 32 * MiB;
constexpr size_t WS_END = WS_BIG + 128 * MiB;
constexpr size_t A_G = 0, A_XR = 40 * MiB, A_Y = 80 * MiB, A_AGG = 120 * MiB, A_CARRY = 124 * MiB;
constexpr size_t B_U = 0, B_V = 32 * MiB, B_Y = 64 * MiB, B_SSV = 96 * MiB;
constexpr size_t C_GCX = 0, C_Y = 96 * MiB;

constexpr int LDS_BYTES = 147456;

namespace pg8 {
constexpr int BM = 256, BK = 64, HALF = 128, HTB = HALF * BK * 2, STAGE_BYTES = 8 * HTB, NXCD = 8, WGM = 8;
__host__ __device__ __forceinline__ int lds_byte(int r, int c) { const int st = (r >> 4) * 2 + (c >> 5), rr = r & 15, cc = c & 31, ob = rr * 64 + cc * 2; return st * 1024 + (ob ^ (((ob >> 9) & 1) << 5)); }
__host__ __device__ __forceinline__ void stage_rc(int b, int& R, int& C) { const int st = b / 1024, sb = b % 1024, swz = sb ^ (((sb >> 9) & 1) << 5); R = (st >> 1) * 16 + swz / 64; C = (st & 1) * 32 + (swz % 64) / 2; }
__host__ __device__ __forceinline__ int perm32(int rho) { const int n = rho >> 4, i = rho & 15; return 8 * (i >> 2) + 4 * n + (i & 3); }

struct Unit { int pm, pn; };
struct Gemm { const bf16_t* A; const bf16_t* Bt; int M, N, K; };

struct StaticOrder {
    int nM, nN, nwg, G, c;
    __host__ __device__ void init(int M_, int N_, int G_, int c_) { nM = M_ / BM; nN = N_ / BM; nwg = nM * nN; G = G_; c = c_; }
    __host__ __device__ bool next(int i, Unit& u) const {
        const long L = (long)i * G + c; if (L >= nwg) return false;
        int wgid = (int)L; { const int q = nwg / NXCD, r = nwg % NXCD, xcd = wgid % NXCD, off = wgid / NXCD; wgid = (xcd < r ? xcd * (q + 1) : r * (q + 1) + (xcd - r) * q) + off; }
        const int nig = WGM * nN, gid = wgid / nig, fm = gid * WGM, gsz = (nM - fm) < WGM ? (nM - fm) : WGM;
        u.pm = fm + ((wgid % nig) % gsz); u.pn = (wgid % nig) / gsz; return true;
    }
};

__device__ __forceinline__ unsigned cvt_pk_bf16(float lo, float hi) { unsigned r; asm volatile("v_cvt_pk_bf16_f32 %0, %1, %2" : "=v"(r) : "v"(lo), "v"(hi)); return r; }
__device__ __forceinline__ float fast_rcp(float x) { return __builtin_amdgcn_rcpf(x); }
__device__ __forceinline__ float fast_exp2(float x) { return __builtin_amdgcn_exp2f(x); }
__device__ __forceinline__ float sigmoidf_(float z) { return fast_rcp(1.0f + fast_exp2(-LOG2E * z)); }
__device__ __forceinline__ float gelu_tanh(float x) { const float z = x * (1.0f + 0.044715f * x * x); return x * fast_rcp(1.0f + fast_exp2(-2.0f * 0.7978845608028654f * LOG2E * z)); }

__device__ __forceinline__ float row_rs(const float* ssp, int row, int fq) {
    const f32x4 p = *(const f32x4*)(ssp + (size_t)row * 16 + 4 * fq);
    float s = (p[0] + p[1]) + (p[2] + p[3]);
    s += __shfl_xor(s, 16); s += __shfl_xor(s, 32);
    return __builtin_amdgcn_rsqf(s * (1.0f / 1024.0f) + EPS);
}

template <int MODE> struct EpiAct {
    static constexpr bool PERM = true, AFTER_DRAIN = false;
    bf16_t* O; int ldc; int split_cols; size_t split_stride; const float* ssp; float* ssv;
    __device__ __forceinline__ void operator()(const f32x4 (&acc)[2][2][4][2], const Unit& u, int wr, int wc, int fr, int fq) const {
        const int row0 = u.pm * BM + wr * 64 + fr; int colt = u.pn * BM; bf16_t* base = O; int t = 0;
        if (split_cols) { t = colt / split_cols; base += (size_t)t * split_stride; colt -= t * split_cols; }
        const int col0 = colt + wc * 32 + 8 * fq;
#pragma unroll
        for (int ai = 0; ai < 2; ++ai)
#pragma unroll
            for (int m = 0; m < 4; ++m) {
                const int row = row0 + ai * HALF + m * 16;
                const float rs = row_rs(ssp, row, fq);
                bf16_t* rowp = base + (size_t)row * ldc + col0; float vs = 0.f;
#pragma unroll
                for (int bj = 0; bj < 2; ++bj) {
                    f32x4 v0 = acc[ai][bj][m][0] * rs, v1 = acc[ai][bj][m][1] * rs;
                    if (MODE == 0) { if (t == 0) {
#pragma unroll
                        for (int j = 0; j < 4; ++j) { v0[j] = gelu_tanh(v0[j]); v1[j] = gelu_tanh(v1[j]); } } }
                    if (MODE == 1) {
#pragma unroll
                        for (int j = 0; j < 4; ++j) { const float a = fmaxf(v0[j], 0.f), b = fmaxf(v1[j], 0.f); v0[j] = a * a; v1[j] = b * b; } }
                    if (MODE == 2) {
#pragma unroll
                        for (int j = 0; j < 4; ++j) { v0[j] = gelu_tanh(v0[j]); v1[j] = gelu_tanh(v1[j]); }
                        vs += (v0[0] * v0[0] + v0[1] * v0[1]) + (v0[2] * v0[2] + v0[3] * v0[3]) + (v1[0] * v1[0] + v1[1] * v1[1]) + (v1[2] * v1[2] + v1[3] * v1[3]); }
                    u32x4 w; w.x = cvt_pk_bf16(v0[0], v0[1]); w.y = cvt_pk_bf16(v0[2], v0[3]); w.z = cvt_pk_bf16(v1[0], v1[1]); w.w = cvt_pk_bf16(v1[2], v1[3]);
                    *(u32x4*)(rowp + bj * HALF) = w;
                }
                if (MODE == 2) { vs += __shfl_xor(vs, 16); vs += __shfl_xor(vs, 32);
                    if (t == 1 && fq == 0) ssv[(size_t)row * 16 + (u.pn - 4) * 4 + wc] = vs; }
            }
    }
};
struct EpiRes {
    static constexpr bool PERM = true, AFTER_DRAIN = false;
    bf16_t* xb; float* ssp;
    __device__ __forceinline__ void operator()(const f32x4 (&acc)[2][2][4][2], const Unit& u, int wr, int wc, int fr, int fq) const {
        const int row0 = u.pm * BM + wr * 64 + fr, col0 = u.pn * BM + wc * 32 + 8 * fq;
#pragma unroll
        for (int ai = 0; ai < 2; ++ai)
#pragma unroll
            for (int m = 0; m < 4; ++m) {
                const int row = row0 + ai * HALF + m * 16; float ss = 0.f;
#pragma unroll
                for (int bj = 0; bj < 2; ++bj) {
                    const size_t off = (size_t)row * D + col0 + bj * HALF;
                    const u32x4 b = *(const u32x4*)(xb + off);
                    const f32x4 a0 = acc[ai][bj][m][0], a1 = acc[ai][bj][m][1];
                    u32x4 w;
                    w.x = cvt_pk_bf16(a0[0] + __uint_as_float(b.x << 16), a0[1] + __uint_as_float(b.x & 0xffff0000u));
                    w.y = cvt_pk_bf16(a0[2] + __uint_as_float(b.y << 16), a0[3] + __uint_as_float(b.y & 0xffff0000u));
                    w.z = cvt_pk_bf16(a1[0] + __uint_as_float(b.z << 16), a1[1] + __uint_as_float(b.z & 0xffff0000u));
                    w.w = cvt_pk_bf16(a1[2] + __uint_as_float(b.w << 16), a1[3] + __uint_as_float(b.w & 0xffff0000u));
                    *(u32x4*)(xb + off) = w;
                    const float r0 = __uint_as_float(w.x << 16), r1 = __uint_as_float(w.x & 0xffff0000u), r2 = __uint_as_float(w.y << 16), r3 = __uint_as_float(w.y & 0xffff0000u);
                    const float r4 = __uint_as_float(w.z << 16), r5 = __uint_as_float(w.z & 0xffff0000u), r6 = __uint_as_float(w.w << 16), r7 = __uint_as_float(w.w & 0xffff0000u);
                    ss += (r0 * r0 + r1 * r1) + (r2 * r2 + r3 * r3) + (r4 * r4 + r5 * r5) + (r6 * r6 + r7 * r7);
                }
                ss += __shfl_xor(ss, 16); ss += __shfl_xor(ss, 32);
                if (fq == 0) ssp[(size_t)row * 16 + u.pn * 4 + wc] = ss;
            }
    }
};

template <class Epi, class Sched, bool ALIGN_EPI = true>
__device__ __forceinline__ void gemm_phase(LAS unsigned char* lds, const Gemm g, const Sched& S, const Epi& E) {
    int tid_o = threadIdx.x; asm volatile("" : "+v"(tid_o));
    const int tid = tid_o, wid = __builtin_amdgcn_readfirstlane(tid >> 6), lane = tid & 63, wr = wid >> 2, wc = wid & 3, fr = lane & 15, fq = lane >> 4;
    const int K = g.K, nt = K / BK;
    unsigned voffA[2], voffB[2];
#pragma unroll
    for (int i = 0; i < 2; ++i) { int R, C; stage_rc(tid * 16 + i * 8192, R, C); const int Rb = Epi::PERM ? ((R & ~31) + perm32(R & 31)) : R;
        voffA[i] = (unsigned)(R * K + C) * 2u; voffB[i] = (unsigned)(Rb * K + C) * 2u; }
    const size_t kstep = (size_t)(BK * 2);
    const size_t hstep = (size_t)HALF * K * 2;
    const size_t tstep = 2 * hstep;
    const unsigned ldsw = (unsigned)wid * 1024u;
    const int aoff = lds_byte(wr * 64 + fr, fq * 8), boff = lds_byte(wc * 32 + fr, fq * 8);
#define PG8_SA(b, h) (((b) * 2 + (h)) * HTB)
#define PG8_SB(b, h) ((4 + (b) * 2 + (h)) * HTB)
#define PG8_STAGE(bufoff, gbase, voff) do { _Pragma("unroll") for (int _i = 0; _i < 2; ++_i) \
        __builtin_amdgcn_global_load_lds((const unsigned*)((const char*)(gbase) + (voff)[_i]), (LAS unsigned*)(lds + (bufoff) + ldsw + _i * 8192), 16, 0, 0); } while (0)
#define PG8_LDA(dst, b, h) do { _Pragma("unroll") for (int m = 0; m < 4; ++m) _Pragma("unroll") for (int k = 0; k < 2; ++k) dst[m][k] = *(const LAS bf16x8*)(lds + PG8_SA(b, h) + aoff + m * 2048 + k * 1024); } while (0)
#define PG8_LDB(dst, b, h) do { _Pragma("unroll") for (int n = 0; n < 2; ++n) _Pragma("unroll") for (int k = 0; k < 2; ++k) dst[n][k] = *(const LAS bf16x8*)(lds + PG8_SB(b, h) + boff + n * 2048 + k * 1024); } while (0)
#define PG8_MMA(ai, bj, At, Bt) do { __builtin_amdgcn_s_setprio(1); _Pragma("unroll") for (int m = 0; m < 4; ++m) _Pragma("unroll") for (int n = 0; n < 2; ++n) _Pragma("unroll") for (int k = 0; k < 2; ++k) \
        acc[ai][bj][m][n] = __builtin_amdgcn_mfma_f32_16x16x32_bf16(Bt[n][k], At[m][k], acc[ai][bj][m][n], 0, 0, 0); __builtin_amdgcn_s_setprio(0); } while (0)
#define PG8_WAIT_V(n) asm volatile("s_waitcnt vmcnt(" #n ")" ::: "memory")
#define PG8_WAIT_L(n) asm volatile("s_waitcnt lgkmcnt(" #n ")" ::: "memory")
#define PG8_BAR __builtin_amdgcn_s_barrier()
#define PG8_SCHED __builtin_amdgcn_sched_barrier(0)
    Unit cur, nxt; int ui = 0;
    if (!S.next(0, cur)) return;
    f32x4 acc[2][2][4][2];
#pragma unroll
    for (int a = 0; a < 2; ++a)
#pragma unroll
        for (int b = 0; b < 2; ++b)
#pragma unroll
            for (int m = 0; m < 4; ++m)
#pragma unroll
                for (int n = 0; n < 2; ++n) acc[a][b][m][n] = (f32x4){0.f, 0.f, 0.f, 0.f};
    bf16x8 At[4][2], B0[2][2], B1[2][2];
    const char* cA = (const char*)g.A + (size_t)cur.pm * tstep; const char* cB = (const char*)g.Bt + (size_t)cur.pn * tstep;
    PG8_STAGE(PG8_SB(0, 0), cB, voffB); PG8_STAGE(PG8_SB(0, 1), cB + hstep, voffB); PG8_STAGE(PG8_SA(0, 0), cA, voffA); PG8_STAGE(PG8_SA(0, 1), cA + hstep, voffA);
    if (wr == 1) PG8_BAR;
    PG8_WAIT_V(2); PG8_BAR;
    PG8_STAGE(PG8_SB(1, 0), cB + kstep, voffB); PG8_STAGE(PG8_SA(1, 0), cA + kstep, voffA); PG8_STAGE(PG8_SB(1, 1), cB + hstep + kstep, voffB);
    PG8_WAIT_V(6); PG8_BAR;
    for (;;) {
        const bool has_next = S.next(ui + 1, nxt);
        const char* nA = has_next ? (const char*)g.A + (size_t)nxt.pm * tstep : cA; const char* nB = has_next ? (const char*)g.Bt + (size_t)nxt.pn * tstep : cB;
        for (int t = 0; t < nt; t += 2) {
            const bool last = (t == nt - 2);
            const char* a1 = cA + (size_t)(t + 1) * kstep;
            const char* a2 = last ? nA : cA + (size_t)(t + 2) * kstep; const char* b2 = last ? nB : cB + (size_t)(t + 2) * kstep;
            const char* a3 = a2 + kstep; const char* b3 = b2 + kstep;
            PG8_LDB(B0, 0, 0); PG8_LDB(B1, 0, 1); PG8_SCHED; PG8_LDA(At, 0, 0); PG8_STAGE(PG8_SA(1, 1), a1 + hstep, voffA);
            PG8_WAIT_V(8); PG8_WAIT_L(0); PG8_BAR; PG8_MMA(0, 0, At, B0); PG8_MMA(0, 1, At, B1); PG8_BAR; PG8_SCHED;
            PG8_LDA(At, 0, 1); PG8_STAGE(PG8_SB(0, 0), b2, voffB); PG8_STAGE(PG8_SB(0, 1), b2 + hstep, voffB); PG8_STAGE(PG8_SA(0, 0), a2, voffA);
            PG8_WAIT_V(8); PG8_WAIT_L(0); PG8_BAR; PG8_MMA(1, 0, At, B0); PG8_MMA(1, 1, At, B1); PG8_BAR; PG8_SCHED;
            PG8_LDB(B0, 1, 0); PG8_LDB(B1, 1, 1); PG8_SCHED; PG8_LDA(At, 1, 0); PG8_STAGE(PG8_SA(0, 1), a2 + hstep, voffA);
            PG8_WAIT_V(8); PG8_WAIT_L(0); PG8_BAR; PG8_MMA(0, 0, At, B0); PG8_MMA(0, 1, At, B1); PG8_BAR; PG8_SCHED;
            PG8_LDA(At, 1, 1); PG8_STAGE(PG8_SB(1, 0), b3, voffB); PG8_STAGE(PG8_SB(1, 1), b3 + hstep, voffB); PG8_STAGE(PG8_SA(1, 0), a3, voffA);
            PG8_WAIT_V(8); PG8_WAIT_L(0); PG8_BAR; PG8_MMA(1, 0, At, B0); PG8_MMA(1, 1, At, B1); PG8_BAR; PG8_SCHED;
        }
        if constexpr (ALIGN_EPI) { if (wr == 0) PG8_BAR; }
        E(acc, cur, wr, wc, fr, fq);
        if (!has_next) break;
#pragma unroll
        for (int a = 0; a < 2; ++a)
#pragma unroll
            for (int b = 0; b < 2; ++b)
#pragma unroll
                for (int m = 0; m < 4; ++m)
#pragma unroll
                    for (int n = 0; n < 2; ++n) acc[a][b][m][n] = (f32x4){0.f, 0.f, 0.f, 0.f};
        cur = nxt; cA = nA; cB = nB; ++ui;
        if constexpr (ALIGN_EPI) { if (wr == 1) PG8_BAR; }
    }
    PG8_WAIT_V(0);
    if constexpr (!ALIGN_EPI) { if (wr == 0) PG8_BAR; }
    PG8_BAR;
#undef PG8_SA
#undef PG8_SB
#undef PG8_STAGE
#undef PG8_LDA
#undef PG8_LDB
#undef PG8_MMA
#undef PG8_WAIT_V
#undef PG8_WAIT_L
#undef PG8_BAR
#undef PG8_SCHED
}
}
using pg8::cvt_pk_bf16;

__device__ __forceinline__ float bf_lo(unsigned w) { return __uint_as_float(w << 16); }
__device__ __forceinline__ float bf_hi(unsigned w) { return __uint_as_float(w & 0xffff0000u); }
__device__ __forceinline__ float wave_sum(float v) {
#pragma unroll
    for (int o = 1; o < 64; o <<= 1) v += __shfl_xor(v, o);
    return v;
}
#define LDS_WAIT() asm volatile("s_waitcnt lgkmcnt(0)" ::: "memory")

struct Args { const float* in[23]; float* out; unsigned char* ws; int lo, hi; };

struct P0Item { const float* W; const float* gain; bf16_t* WT; int K, N, k0, n0; };
__device__ __forceinline__ P0Item p0_decode(const Args& a, unsigned char* ws, int it) {
    P0Item d; d.gain = nullptr; int r = it;
    if (r < 2560)        { const int j = r / 1280; r -= j * 1280; d.W = a.in[4] + (size_t)j * D * 2 * DR; d.gain = a.in[1] + (size_t)(3 * j) * D; d.WT = (bf16_t*)(ws + W_AWIN) + (size_t)j * D * 2 * DR; d.K = D; d.N = 2 * DR; }
    else if (r < 3840)   { r -= 2560; const int j = r / 640; r -= j * 640; d.W = a.in[12] + (size_t)j * DR * D; d.WT = (bf16_t*)(ws + W_AWOUT) + (size_t)j * DR * D; d.K = DR; d.N = D; }
    else if (r < 4864)   { r -= 3840; d.W = a.in[13]; d.gain = a.in[1] + 1 * D; d.WT = (bf16_t*)(ws + W_BWIN); d.K = D; d.N = 2 * D; }
    else if (r < 5376)   { r -= 4864; d.W = a.in[17]; d.WT = (bf16_t*)(ws + W_BWOUT); d.K = D; d.N = D; }
    else if (r < 6912)   { r -= 5376; d.W = a.in[18]; d.gain = a.in[1] + 2 * D; d.WT = (bf16_t*)(ws + W_CWIN); d.K = D; d.N = 3 * D; }
    else if (r < 7424)   { r -= 6912; d.W = a.in[20]; d.WT = (bf16_t*)(ws + W_CWOUT); d.K = D; d.N = D; }
    else if (r < 15616)  { r -= 7424; const int i = r >> 11; r &= 2047; d.W = a.in[21] + (size_t)i * D * FF; d.gain = a.in[2] + (size_t)i * D; d.WT = (bf16_t*)(ws + W_W1) + (size_t)i * D * FF; d.K = D; d.N = FF; }
    else                 { r -= 15616; const int i = r >> 11; r &= 2047; d.W = a.in[22] + (size_t)i * FF * D; d.WT = (bf16_t*)(ws + W_W2) + (size_t)i * FF * D; d.K = FF; d.N = D; }
    const int nblk = d.N / 32; d.k0 = 64 * (r / nblk); d.n0 = 32 * (r % nblk);
    return d;
}
constexpr int P0_NITEMS = 23808;
__device__ __forceinline__ void p0_load(const P0Item& d, int lane, f32x4 (&R)[8]) {
    const float* p = d.W + (size_t)(d.k0 + (lane >> 3)) * d.N + d.n0 + 4 * (lane & 7);
#pragma unroll
    for (int i = 0; i < 8; ++i) R[i] = __builtin_nontemporal_load((const f32x4*)(p + (size_t)(8 * i) * d.N));
}
__device__ __forceinline__ void p0_store(const P0Item& d, int lane, const f32x4 (&R)[8], LAS float* scr) {
#pragma unroll
    for (int i = 0; i < 8; ++i) { const int kk = 8 * i + (lane >> 3); const float gk = d.gain ? d.gain[d.k0 + kk] : 1.0f; LAS float* s = scr + kk * 33 + 4 * (lane & 7);
        s[0] = R[i][0] * gk; s[1] = R[i][1] * gk; s[2] = R[i][2] * gk; s[3] = R[i][3] * gk; }
    LDS_WAIT(); asm volatile("" ::: "memory");
    const int c = lane & 7;
#pragma unroll
    for (int j = 0; j < 4; ++j) { const int n = (lane >> 3) + 8 * j; const LAS float* s = scr + (8 * c) * 33 + n;
        u32x4 o; o.x = cvt_pk_bf16(s[0 * 33], s[1 * 33]); o.y = cvt_pk_bf16(s[2 * 33], s[3 * 33]); o.z = cvt_pk_bf16(s[4 * 33], s[5 * 33]); o.w = cvt_pk_bf16(s[6 * 33], s[7 * 33]);
        *(u32x4*)(d.WT + (size_t)(d.n0 + n) * d.K + d.k0 + 8 * c) = o; }
    LDS_WAIT(); asm volatile("" ::: "memory");
}

namespace amid {
constexpr int GWS = 104;
constexpr int OFF_GW = 0, OFF_CONST = 160 * GWS * 2  , OFF_CARRY = OFF_CONST + 8 * 80 * 4, OFF_SEG = OFF_CARRY + 16 * 80 * 4, OFF_WAVE = 45056, WAVE_BYTES = 10880;
static_assert(OFF_SEG + 6 * 80 * 2 * 4 <= OFF_WAVE && OFF_WAVE + 8 * WAVE_BYTES <= 131072 + 1024, "amid LDS map");
}
template <bool PASS2>
__device__ __forceinline__ void a_block(LAS unsigned char* lds, int bu, int tid, int lane, int wave, const bf16_t* XR, const bf16_t* G, bf16_t* Y, float* AGG,
                                        const float* conv_w, const float* conv_b, const bf16_t* GW, const float* ga_b, const float* gx_b, const float* lam) {
    using namespace amid;
    const int h = bu & 15, gI = bu >> 4;
    LAS float* CST = (LAS float*)(lds + OFF_CONST);
    LAS float* CAR = (LAS float*)(lds + OFF_CARRY);
    for (int i = tid; i < 160 * 12; i += 512) { const int row = i / 12, ch = i % 12;
        *(LAS u32x4*)(lds + OFF_GW + row * (GWS * 2) + ch * 16) = *(const u32x4*)(GW + ((size_t)(h * 160 + row)) * 96 + ch * 8); }
    if (tid < 80) { const int c = HD * h + tid;
        CST[0 * 80 + tid] = ga_b[c]; CST[1 * 80 + tid] = gx_b[c]; CST[2 * 80 + tid] = -8.0f * log1pf(__expf(-lam[c])) * LOG2E;
        CST[3 * 80 + tid] = conv_w[0 * DR + c]; CST[4 * 80 + tid] = conv_w[1 * DR + c]; CST[5 * 80 + tid] = conv_w[2 * DR + c]; CST[6 * 80 + tid] = conv_w[3 * DR + c]; CST[7 * 80 + tid] = conv_b[c]; }
    if (PASS2) {
        const int cf = 16 * gI, cb0 = cf & ~127, nprev = cf - cb0, Ls = (nprev + 5) / 6;
        LAS float* SEG = (LAS float*)(lds + OFF_SEG);
        if (tid < 480) {
            const int c = tid % 80, sg = tid / 80, st0 = cb0 + sg * Ls, en = (st0 + Ls < cf) ? st0 + Ls : cf;
            f32x2 pv[19];
#pragma unroll
            for (int i = 0; i < 19; ++i) { const int idx = st0 + i; pv[i] = (idx < en) ? *(const f32x2*)(AGG + ((size_t)idx * DR + HD * h + c) * 2) : (f32x2){1.f, 0.f}; }
            float P = 1.f, H = 0.f;
#pragma unroll
            for (int i = 0; i < 19; ++i) { H = pv[i][0] * H + pv[i][1]; P *= pv[i][0]; }
            SEG[(sg * 80 + c) * 2] = P; SEG[(sg * 80 + c) * 2 + 1] = H;
        }
        __syncthreads();
        if (tid < 80) {
            f32x2 pv[16];
#pragma unroll
            for (int i = 0; i < 16; ++i) pv[i] = *(const f32x2*)(AGG + ((size_t)(cf + i) * DR + HD * h + tid) * 2);
            float s = 0.f;
#pragma unroll
            for (int sg = 0; sg < 6; ++sg) s = SEG[(sg * 80 + tid) * 2] * s + SEG[(sg * 80 + tid) * 2 + 1];
#pragma unroll
            for (int i = 0; i < 16; ++i) { CAR[i * 80 + tid] = s; s = pv[i][0] * s + pv[i][1]; }
        }
    }
    __syncthreads();
    LAS unsigned char* Rb = lds + OFF_WAVE + wave * WAVE_BYTES;
    const int m = lane & 15, q = lane >> 4;
    const int tl = 16 * (m >> 2) + (m & 3);
#pragma unroll 1
    for (int it = 0; it < 2; ++it) {
        const int cn = 16 * gI + 8 * it + wave, row0 = cn * 64;
        const bool first = (cn & 127) == 0;
        int ln = lane; asm volatile("" : "+v"(ln));
        u32x4 xr[11];
#pragma unroll
        for (int i = 0; i < 11; ++i) { const int id = ln + 64 * i, r = id / 10, ch = id - r * 10;
            xr[i] = (u32x4){0u, 0u, 0u, 0u};
            if (id < 670 && !(first && r < 3)) xr[i] = *(const u32x4*)(XR + (long)(row0 - 3 + r) * DR + HD * h + 8 * ch); }
#pragma unroll
        for (int i = 0; i < 11; ++i) { const int id = ln + 64 * i, r = id / 10, ch = id - r * 10; if (id < 670) *(LAS u32x4*)(Rb + r * 160 + 16 * (r >> 4) + 16 * ch) = xr[i]; }
        asm volatile("s_waitcnt lgkmcnt(0)" ::: "memory");
        bf16x8 Af[4][3];
#pragma unroll
        for (int ks = 0; ks < 3; ++ks) {
            const int kc0 = 32 * ks + 8 * q; const bool kval = kc0 < HD; const int kcl = kval ? kc0 : 0;
            f32x4 w[4][2], bb[2];
#pragma unroll
            for (int k = 0; k < 4; ++k) { w[k][0] = *(const LAS f32x4*)(CST + (3 + k) * 80 + kcl); w[k][1] = *(const LAS f32x4*)(CST + (3 + k) * 80 + kcl + 4); }
            bb[0] = *(const LAS f32x4*)(CST + 7 * 80 + kcl); bb[1] = *(const LAS f32x4*)(CST + 7 * 80 + kcl + 4);
#pragma unroll
            for (int rt = 0; rt < 4; ++rt) {
                f32x4 a0 = bb[0], a1 = bb[1];
#pragma unroll
                for (int k = 0; k < 4; ++k) {
                    const int ri = tl + 4 * rt + k;
                    const u32x4 xv = *(const LAS u32x4*)(Rb + ri * 160 + 16 * (ri >> 4) + 2 * kcl);
                    a0[0] += w[k][0][0] * bf_lo(xv.x); a0[1] += w[k][0][1] * bf_hi(xv.x); a0[2] += w[k][0][2] * bf_lo(xv.y); a0[3] += w[k][0][3] * bf_hi(xv.y);
                    a1[0] += w[k][1][0] * bf_lo(xv.z); a1[1] += w[k][1][1] * bf_hi(xv.z); a1[2] += w[k][1][2] * bf_lo(xv.w); a1[3] += w[k][1][3] * bf_hi(xv.w);
                }
                u32x4 pk; pk.x = cvt_pk_bf16(a0[0], a0[1]); pk.y = cvt_pk_bf16(a0[2], a0[3]); pk.z = cvt_pk_bf16(a1[0], a1[1]); pk.w = cvt_pk_bf16(a1[2], a1[3]);
                if (!kval) pk = (u32x4){0u, 0u, 0u, 0u};
                Af[rt][ks] = __builtin_bit_cast(bf16x8, pk);
            }
        }
        if (PASS2) {
            u32x4 gr[10];
#pragma unroll
            for (int i = 0; i < 10; ++i) { const int id = ln + 64 * i, r = id / 10, ch = id - r * 10; gr[i] = *(const u32x4*)(G + (size_t)(row0 + r) * DR + HD * h + 8 * ch); }
            asm volatile("s_waitcnt lgkmcnt(0)" ::: "memory");
#pragma unroll
            for (int i = 0; i < 10; ++i) { const int id = ln + 64 * i, r = id / 10, ch = id - r * 10; *(LAS u32x4*)(Rb + r * 160 + 32 * (r >> 4) + 16 * ch) = gr[i]; }
            asm volatile("s_waitcnt lgkmcnt(0)" ::: "memory");
        }
#pragma unroll 1
        for (int nt = 0; nt < 5; ++nt) {
            const int cl = 16 * nt + m;
            bf16x8 Ba[3], Bx[3];
#pragma unroll
            for (int ks = 0; ks < 3; ++ks) {
                Ba[ks] = *(const LAS bf16x8*)(lds + OFF_GW + (cl) * (GWS * 2) + (32 * ks + 8 * q) * 2);
                Bx[ks] = *(const LAS bf16x8*)(lds + OFF_GW + (80 + cl) * (GWS * 2) + (32 * ks + 8 * q) * 2);
            }
            const float ba = CST[0 * 80 + cl], bx = CST[1 * 80 + cl], kc = CST[2 * 80 + cl];
            bf16x8 Iq;
#pragma unroll
            for (int j = 0; j < 8; ++j) Iq[j] = (8 * q + j == 16 * (nt & 1) + m) ? (short)0x3F80 : (short)0;
            f32x4 ar[4], ax[4], ac[4];
#pragma unroll
            for (int rt = 0; rt < 4; ++rt) {
                ar[rt] = (f32x4){0.f, 0.f, 0.f, 0.f}; ax[rt] = ar[rt]; ac[rt] = ar[rt];
#pragma unroll
                for (int ks = 0; ks < 3; ++ks) {
                    ar[rt] = __builtin_amdgcn_mfma_f32_16x16x32_bf16(Af[rt][ks], Ba[ks], ar[rt], 0, 0, 0);
                    ax[rt] = __builtin_amdgcn_mfma_f32_16x16x32_bf16(Af[rt][ks], Bx[ks], ax[rt], 0, 0, 0);
                }
                const bf16x8 Asel = (nt < 2) ? Af[rt][0] : ((nt < 4) ? Af[rt][1] : Af[rt][2]);
                ac[rt] = __builtin_amdgcn_mfma_f32_16x16x32_bf16(Asel, Iq, ac[rt], 0, 0, 0);
            }
            float hl = 0.f, ca = 1.f; float hs[16], cs[16];
#pragma unroll
            for (int rt = 0; rt < 4; ++rt)
#pragma unroll
                for (int i = 0; i < 4; ++i) {
                    const float r = pg8::sigmoidf_(ar[rt][i] + ba), ig = pg8::sigmoidf_(ax[rt][i] + bx);
                    const float a = pg8::fast_exp2(r * kc);
                    const float mult = __builtin_amdgcn_sqrtf(fmaxf(1.0f - a * a, 0.f));
                    const float uu = mult * ig * ac[rt][i];
                    hl = a * hl + uu; ca *= a;
                    if (PASS2) { hs[4 * rt + i] = hl; cs[4 * rt + i] = ca; }
                }
            const float A0 = __shfl(ca, m), H0 = __shfl(hl, m), A1 = __shfl(ca, m + 16), H1 = __shfl(hl, m + 16), A2 = __shfl(ca, m + 32), H2 = __shfl(hl, m + 32);
            if (!PASS2) {
                const float A3 = __shfl(ca, m + 48), H3 = __shfl(hl, m + 48);
                float s = H0; s = A1 * s + H1; s = A2 * s + H2; s = A3 * s + H3;
                const float P = (A0 * A1) * (A2 * A3);
                if (q == 0) *(f32x2*)(AGG + ((size_t)cn * DR + HD * h + cl) * 2) = (f32x2){P, s};
            } else {
                const float s0 = CAR[(8 * it + wave) * 80 + cl];
                const float s1 = A0 * s0 + H0, s2 = A1 * s1 + H1, s3 = A2 * s2 + H2;
                const float sq = q == 0 ? s0 : (q == 1 ? s1 : (q == 2 ? s2 : s3));
                LAS bf16_t* gy = (LAS bf16_t*)(Rb + (16 * q) * 160 + 32 * q + 2 * cl);
#pragma unroll
                for (int st = 0; st < 16; ++st) {
                    const float hv = hs[st] + cs[st] * sq;
                    const float gv = __uint_as_float((unsigned)gy[st * 80] << 16);
                    gy[st * 80] = (bf16_t)(cvt_pk_bf16(hv * gv, 0.f) & 0xffffu);
                }
            }
        }
        if (PASS2) {
            asm volatile("s_waitcnt lgkmcnt(0)" ::: "memory");
#pragma unroll
            for (int i = 0; i < 10; ++i) { const int id = ln + 64 * i, r = id / 10, ch = id - r * 10;
                const u32x4 v = *(const LAS u32x4*)(Rb + r * 160 + 32 * (r >> 4) + 16 * ch);
                *(u32x4*)(Y + (size_t)(row0 + r) * DR + HD * h + 8 * ch) = v; }
            asm volatile("s_waitcnt lgkmcnt(0)" ::: "memory");
        }
    }
    __syncthreads();
}

constexpr int LDV = 136;
__device__ __forceinline__ void sgu_unit(LAS unsigned char* lds, int u, int tid, int lane, int wave, const bf16_t* U, const bf16_t* V, bf16_t* Y,
                                         const float* ssv, const float* ng, const bf16_t* WSb, const float* sbias) {
    const int g = u & 7, cn = u >> 3, row0 = cn * 128;
    LAS bf16_t* vt = (LAS bf16_t*)lds;
    {
        const int c0 = 8 * (tid & 15);
        const f32x4 g0 = *(const f32x4*)(ng + g * 128 + c0), g1 = *(const f32x4*)(ng + g * 128 + c0 + 4);
#pragma unroll
        for (int i = 0; i < 2; ++i) {
            const int s = 2 * ((tid >> 4) + 32 * i);
            const u32x4 va = *(const u32x4*)(V + (size_t)(row0 + s) * D + g * 128 + c0), vb = *(const u32x4*)(V + (size_t)(row0 + s + 1) * D + g * 128 + c0);
            float sa = 0.f, sb = 0.f;
#pragma unroll
            for (int k = 0; k < 4; ++k) { const f32x4 pa = *(const f32x4*)(ssv + (size_t)(row0 + s) * 16 + 4 * k), pb = *(const f32x4*)(ssv + (size_t)(row0 + s + 1) * 16 + 4 * k);
                sa += (pa[0] + pa[1]) + (pa[2] + pa[3]); sb += (pb[0] + pb[1]) + (pb[2] + pb[3]); }
            const float ra = __builtin_amdgcn_rsqf(sa * (1.0f / 1024.0f) + EPS), rb = __builtin_amdgcn_rsqf(sb * (1.0f / 1024.0f) + EPS);
            LAS unsigned* dst = (LAS unsigned*)(vt + s);
            dst[(c0 + 0) * (LDV / 2)] = cvt_pk_bf16(bf_lo(va.x) * ra * g0[0], bf_lo(vb.x) * rb * g0[0]);
            dst[(c0 + 1) * (LDV / 2)] = cvt_pk_bf16(bf_hi(va.x) * ra * g0[1], bf_hi(vb.x) * rb * g0[1]);
            dst[(c0 + 2) * (LDV / 2)] = cvt_pk_bf16(bf_lo(va.y) * ra * g0[2], bf_lo(vb.y) * rb * g0[2]);
            dst[(c0 + 3) * (LDV / 2)] = cvt_pk_bf16(bf_hi(va.y) * ra * g0[3], bf_hi(vb.y) * rb * g0[3]);
            dst[(c0 + 4) * (LDV / 2)] = cvt_pk_bf16(bf_lo(va.z) * ra * g1[0], bf_lo(vb.z) * rb * g1[0]);
            dst[(c0 + 5) * (LDV / 2)] = cvt_pk_bf16(bf_hi(va.z) * ra * g1[1], bf_hi(vb.z) * rb * g1[1]);
            dst[(c0 + 6) * (LDV / 2)] = cvt_pk_bf16(bf_lo(va.w) * ra * g1[2], bf_lo(vb.w) * rb * g1[2]);
            dst[(c0 + 7) * (LDV / 2)] = cvt_pk_bf16(bf_hi(va.w) * ra * g1[3], bf_hi(vb.w) * rb * g1[3]);
        }
    }
    __syncthreads();
    {
        const int m = lane & 15, q = lane >> 4, t = 16 * wave + m, kmax = wave >> 1;
        bf16x8 Bw[4];
#pragma unroll
        for (int ks = 0; ks < 4; ++ks) { Bw[ks] = (bf16x8){0, 0, 0, 0, 0, 0, 0, 0}; if (ks <= kmax) Bw[ks] = *(const bf16x8*)(WSb + ((size_t)(g * 128 + t)) * 128 + 32 * ks + 8 * q); }
        const float bias = sbias[g * 128 + t];
#pragma unroll
        for (int p = 0; p < 4; ++p) {
            f32x4 ac[2];
#pragma unroll
            for (int e = 0; e < 2; ++e) {
                ac[e] = (f32x4){0.f, 0.f, 0.f, 0.f};
                const int cc = 32 * p + 8 * (m >> 2) + 4 * e + (m & 3);
#pragma unroll
                for (int ks = 0; ks < 4; ++ks) if (ks <= kmax) {
                    const bf16x8 Afr = *(const LAS bf16x8*)(vt + cc * LDV + 32 * ks + 8 * q);
                    ac[e] = __builtin_amdgcn_mfma_f32_16x16x32_bf16(Afr, Bw[ks], ac[e], 0, 0, 0);
                }
            }
            const size_t off = (size_t)(row0 + t) * D + g * 128 + 32 * p + 8 * q;
            const u32x4 uv = *(const u32x4*)(U + off);
            u32x4 o;
            o.x = cvt_pk_bf16(bf_lo(uv.x) * (ac[0][0] + bias), bf_hi(uv.x) * (ac[0][1] + bias));
            o.y = cvt_pk_bf16(bf_lo(uv.y) * (ac[0][2] + bias), bf_hi(uv.y) * (ac[0][3] + bias));
            o.z = cvt_pk_bf16(bf_lo(uv.z) * (ac[1][0] + bias), bf_hi(uv.z) * (ac[1][1] + bias));
            o.w = cvt_pk_bf16(bf_lo(uv.w) * (ac[1][2] + bias), bf_hi(uv.w) * (ac[1][3] + bias));
            *(u32x4*)(Y + off) = o;
        }
    }
    __syncthreads();
}


#define XB_TMO      128
#define XB_XCNT(j)  (256  + 64 * (j))
#define XB_XSUB(j)  (1280 + 64 * (j))
#define XB_XGEN(j)  (2304 + 64 * (j))
#define XB_TOP      3328
#define XB_TOPGEN   3392
#define XCD_BAR_WORDS 3456
#define XB_SPIN_CAP (1u << 18)
__device__ __forceinline__ unsigned xb_ld(unsigned* p)              { return __hip_atomic_load(p, __ATOMIC_RELAXED, __HIP_MEMORY_SCOPE_AGENT); }
__device__ __forceinline__ unsigned xb_add(unsigned* p, unsigned v) { return __hip_atomic_fetch_add(p, v, __ATOMIC_RELAXED, __HIP_MEMORY_SCOPE_AGENT); }
__device__ __forceinline__ unsigned xb_xcc_id() { return (unsigned)__builtin_amdgcn_s_getreg((3 << 11) | 20) & 0xFu; }
#define XB_SPIN(cond, bar) do { unsigned _sp = 0; while (cond) { __builtin_amdgcn_s_sleep(1); \
    if ((++_sp & 255u) == 0u) { if (xb_ld(&(bar)[XB_TMO])) break; if (_sp > XB_SPIN_CAP) { atomicAdd(&(bar)[XB_TMO], 1u); break; } } } } while (0)
struct XcdBarrier { unsigned* bar; unsigned x; volatile LAS unsigned* st; };
__device__ __forceinline__ XcdBarrier xcd_barrier_post(unsigned* bar, volatile LAS unsigned* st) {
    XcdBarrier b; b.bar = bar; b.x = xb_xcc_id(); b.st = st;
    if (threadIdx.x == 0) (void)xb_add(&bar[XB_XCNT(b.x)], 1u);
    return b;
}
__device__ __forceinline__ void xcd_barrier_complete(unsigned* bar, unsigned x, unsigned& nloc, unsigned& nx) {
    const unsigned G = gridDim.x * gridDim.y * gridDim.z;
    unsigned sum, cnt, mine, sp = 0u;
    for (;;) {
        sum = 0u; cnt = 0u; mine = 0u;
#pragma unroll
        for (unsigned j = 0; j < 16; ++j) { const unsigned c = xb_ld(&bar[XB_XCNT(j)]); sum += c; cnt += (c > 0u) ? 1u : 0u; mine = (j == x) ? c : mine; }
        if (sum == G) break;
        __builtin_amdgcn_s_sleep(1);
        if ((++sp & 255u) == 0u) { if (xb_ld(&bar[XB_TMO])) break; if (sp > XB_SPIN_CAP) { atomicAdd(&bar[XB_TMO], 1u); break; } }
    }
    nloc = mine > 0u ? mine : 1u; nx = cnt > 0u ? cnt : 1u;
}
__device__ __forceinline__ void xcd_barrier(const XcdBarrier& b) {
    asm volatile("s_waitcnt vmcnt(0)" ::: "memory");
    __syncthreads();
    if (threadIdx.x == 0) {
        unsigned* bar = b.bar;
        __builtin_amdgcn_s_waitcnt(0);
        unsigned nloc = b.st[0], nx = b.st[1];
        if (nloc == 0u) { xcd_barrier_complete(bar, b.x, nloc, nx); b.st[0] = nloc; b.st[1] = nx; }
        const unsigned old = xb_add(&bar[XB_XSUB(b.x)], 1u);
        const unsigned gen = old / nloc;
        if (old + 1u == (gen + 1u) * nloc) {
            __builtin_amdgcn_fence(__ATOMIC_RELEASE, "agent");
            asm volatile("s_waitcnt vmcnt(0)" ::: "memory");
            const unsigned og = xb_add(&bar[XB_TOP], 1u);
            const unsigned tg = og / nx;
            if (og + 1u == (tg + 1u) * nx) xb_add(&bar[XB_TOPGEN], 1u);
            else XB_SPIN(xb_ld(&bar[XB_TOPGEN]) == tg, bar);
            __builtin_amdgcn_fence(__ATOMIC_ACQUIRE, "agent");
            xb_add(&bar[XB_XGEN(b.x)], 1u);
            asm volatile("s_waitcnt vmcnt(0)" ::: "memory");
        } else {
            XB_SPIN(xb_ld(&bar[XB_XGEN(b.x)]) == gen, bar);
            __builtin_amdgcn_fence(__ATOMIC_ACQUIRE, "agent");
            asm volatile("s_waitcnt vmcnt(0)" ::: "memory");
        }
    }
    __syncthreads();
}

__global__ void __launch_bounds__(512, 2) trunk_fwd(Args args) {
    extern __shared__ __attribute__((aligned(16))) unsigned char lds_raw[];
    LAS unsigned char* lds = (LAS unsigned char*)lds_raw;
    const int G_ = gridDim.x, bx = blockIdx.x;
    const int NGW = G_ * 8, NGT = G_ * 512;
#define PHASE_IDS() int tid = threadIdx.x; asm volatile("" : "+v"(tid)); const int lane = tid & 63, wave = __builtin_amdgcn_readfirstlane(tid >> 6), gw = bx * 8 + wave, gtid = bx * 512 + tid; (void)lane; (void)wave; (void)gw; (void)gtid
    unsigned char* ws = args.ws;
    float* X = args.out;
    float* SSP = (float*)(ws + WS_SSP);
    bf16_t* XB = (bf16_t*)(ws + WS_XB);
    unsigned char* BIG = ws + WS_BIG;
    const int lo = args.lo, hi = args.hi;
    int ph = 0;
#define RUN() (ph >= lo && ph < hi)
    volatile LAS unsigned* bst = (volatile LAS unsigned*)(lds + 135168);
    if (threadIdx.x < 2) bst[threadIdx.x] = 0u;
    __syncthreads();
    XcdBarrier xbar; xbar.bar = (unsigned*)(ws + WS_BAR); xbar.x = 0; xbar.st = bst;
#define SEAM() do { ++ph; if (ph > lo && ph < hi) { if (ph == 1) { cg::this_grid().sync(); xbar = xcd_barrier_post((unsigned*)(ws + WS_BAR), bst); } else xcd_barrier(xbar); } } while (0)

    _Pragma("unroll 1") for (int rep_ = 0; rep_ < (RUN() ? REP_0 : 0); ++rep_) { PHASE_IDS();
        if (bx == 0) for (int i = tid; i < XCD_BAR_WORDS; i += 512) ((unsigned*)(ws + WS_BAR))[i] = 0u;
        LAS float* scr = (LAS float*)(lds + wave * 16384);
        {
            f32x4 R0[8], R1[8];
            int it = gw;
            if (it < P0_NITEMS) { const P0Item d = p0_decode(args, ws, it); p0_load(d, lane, R0); }
#pragma unroll 1
            for (; it < P0_NITEMS; it += 2 * NGW) {
                const int it1 = it + NGW, it2 = it + 2 * NGW;
                if (it1 < P0_NITEMS) { const P0Item d1 = p0_decode(args, ws, it1); p0_load(d1, lane, R1); }
                { const P0Item d = p0_decode(args, ws, it); p0_store(d, lane, R0, scr); }
                if (it2 < P0_NITEMS) { const P0Item d2 = p0_decode(args, ws, it2); p0_load(d2, lane, R0); }
                if (it1 < P0_NITEMS) { const P0Item d1 = p0_decode(args, ws, it1); p0_store(d1, lane, R1, scr); }
            }
        }
        for (int id = gtid; id < 2 * NH * 2 * HD * 12; id += NGT) {
            const int k8 = id % 12, n = (id / 12) % HD, qq = (id / (12 * HD)) & 1, jh = id / (12 * HD * 2);
            const float* Wg = (qq ? args.in[9] : args.in[7]) + (size_t)jh * HD * HD;
            float v[8];
#pragma unroll
            for (int j = 0; j < 8; ++j) { const int k = 8 * k8 + j; v[j] = (k < HD) ? Wg[k * HD + n] : 0.f; }
            u32x4 o; o.x = cvt_pk_bf16(v[0], v[1]); o.y = cvt_pk_bf16(v[2], v[3]); o.z = cvt_pk_bf16(v[4], v[5]); o.w = cvt_pk_bf16(v[6], v[7]);
            *(u32x4*)((bf16_t*)(ws + WS_GW) + (size_t)id * 8) = o;
        }
        for (int id = gtid; id < 8 * 128 * 16; id += NGT) {
            const int s8 = id & 15, t = (id >> 4) & 127;
            const float* p = args.in[15] + (size_t)id * 8; float v[8];
#pragma unroll
            for (int j = 0; j < 8; ++j) v[j] = (8 * s8 + j <= t) ? p[j] : 0.f;
            u32x4 o; o.x = cvt_pk_bf16(v[0], v[1]); o.y = cvt_pk_bf16(v[2], v[3]); o.z = cvt_pk_bf16(v[4], v[5]); o.w = cvt_pk_bf16(v[6], v[7]);
            *(u32x4*)((bf16_t*)(ws + WS_WSB) + (size_t)id * 8) = o;
        }
        const float* x = args.in[0];
        for (int r = gw; r < M; r += 2 * NGW) {
            const int r1 = r + NGW;
            f32x4 va[4], vb[4];
#pragma unroll
            for (int j = 0; j < 4; ++j) { va[j] = __builtin_nontemporal_load((const f32x4*)(x + (size_t)r * D) + lane + 64 * j); vb[j] = (r1 < M) ? __builtin_nontemporal_load((const f32x4*)(x + (size_t)r1 * D) + lane + 64 * j) : (f32x4){0.f, 0.f, 0.f, 0.f}; }
            float sa = 0.f, sb = 0.f;
            unsigned long long* oa = (unsigned long long*)(XB + (size_t)r * D) + lane; unsigned long long* ob = (unsigned long long*)(XB + (size_t)r1 * D) + lane;
#pragma unroll
            for (int j = 0; j < 4; ++j) {
                sa += (va[j][0] * va[j][0] + va[j][1] * va[j][1]) + (va[j][2] * va[j][2] + va[j][3] * va[j][3]);
                sb += (vb[j][0] * vb[j][0] + vb[j][1] * vb[j][1]) + (vb[j][2] * vb[j][2] + vb[j][3] * vb[j][3]);
                oa[64 * j] = (unsigned long long)cvt_pk_bf16(va[j][0], va[j][1]) | ((unsigned long long)cvt_pk_bf16(va[j][2], va[j][3]) << 32);
                if (r1 < M) ob[64 * j] = (unsigned long long)cvt_pk_bf16(vb[j][0], vb[j][1]) | ((unsigned long long)cvt_pk_bf16(vb[j][2], vb[j][3]) << 32);
            }
            sa = wave_sum(sa); sb = wave_sum(sb);
            if (lane < 16) { SSP[(size_t)r * 16 + lane] = (lane == 0) ? sa : 0.f; if (r1 < M) SSP[(size_t)r1 * 16 + lane] = (lane == 0) ? sb : 0.f; }
        }
    }
    SEAM();

#pragma unroll 1
    for (int L = 0; L < 4; ++L) {
        const int kind = L % 3, j = L / 3;
        const bf16_t* Ymix; const bf16_t* Wout; int Kout;
        if (kind == 0) {
            bf16_t* Gb = (bf16_t*)(BIG + A_G); bf16_t* XRb = (bf16_t*)(BIG + A_XR); bf16_t* Yb = (bf16_t*)(BIG + A_Y);
            float* AGG = (float*)(BIG + A_AGG);
            _Pragma("unroll 1") for (int rep_ = 0; rep_ < (RUN() ? REP_1 : 0); ++rep_) { PHASE_IDS();
                pg8::Gemm g{XB, (const bf16_t*)(ws + W_AWIN) + (size_t)j * D * 2 * DR, M, 2 * DR, D}; pg8::StaticOrder S; S.init(M, 2 * DR, G_, bx);
                pg8::EpiAct<0> E{Gb, DR, DR, (size_t)(A_XR - A_G) / 2, SSP, nullptr};
                pg8::gemm_phase<pg8::EpiAct<0>, pg8::StaticOrder>(lds, g, S, E);
            }
            SEAM();
            const float* cw = args.in[5] + (size_t)j * 4 * DR; const float* cb = args.in[6] + (size_t)j * DR;
            const bf16_t* GWl = (const bf16_t*)(ws + WS_GW) + (size_t)j * NH * 2 * HD * 96;
            const float* gab = args.in[8] + (size_t)j * DR; const float* gxb = args.in[10] + (size_t)j * DR; const float* lam = args.in[11] + (size_t)j * DR;
            _Pragma("unroll 1") for (int rep_ = 0; rep_ < (RUN() ? REP_2 : 0); ++rep_) { PHASE_IDS();
#pragma unroll 1
                for (int bu = bx; bu < 256; bu += G_) a_block<false>(lds, bu, tid, lane, wave, XRb, Gb, Yb, AGG, cw, cb, GWl, gab, gxb, lam);
            }
            SEAM();
            _Pragma("unroll 1") for (int rep_ = 0; rep_ < (RUN() ? REP_4 : 0); ++rep_) { PHASE_IDS();
#pragma unroll 1
                for (int bu = bx; bu < 256; bu += G_) a_block<true>(lds, bu, tid, lane, wave, XRb, Gb, Yb, AGG, cw, cb, GWl, gab, gxb, lam);
            }
            SEAM();
            Ymix = Yb; Wout = (const bf16_t*)(ws + W_AWOUT) + (size_t)j * DR * D; Kout = DR;
        } else if (kind == 1) {
            bf16_t* Ub = (bf16_t*)(BIG + B_U); bf16_t* Vb = (bf16_t*)(BIG + B_V); bf16_t* Yb = (bf16_t*)(BIG + B_Y); float* SSV = (float*)(BIG + B_SSV);
            _Pragma("unroll 1") for (int rep_ = 0; rep_ < (RUN() ? REP_5 : 0); ++rep_) { PHASE_IDS();
                pg8::Gemm g{XB, (const bf16_t*)(ws + W_BWIN), M, 2 * D, D}; pg8::StaticOrder S; S.init(M, 2 * D, G_, bx);
                pg8::EpiAct<2> E{Ub, D, D, (size_t)(B_V - B_U) / 2, SSP, SSV};
                pg8::gemm_phase<pg8::EpiAct<2>, pg8::StaticOrder>(lds, g, S, E);
            }
            SEAM();
            _Pragma("unroll 1") for (int rep_ = 0; rep_ < (RUN() ? REP_6 : 0); ++rep_) { PHASE_IDS();
#pragma unroll 1
                for (int u = bx; u < 128 * 8; u += G_) sgu_unit(lds, u, tid, lane, wave, Ub, Vb, Yb, SSV, args.in[14], (const bf16_t*)(ws + WS_WSB), args.in[16]);
            }
            SEAM();
            Ymix = Yb; Wout = (const bf16_t*)(ws + W_BWOUT); Kout = D;
        } else {
            bf16_t* GCX = (bf16_t*)(BIG + C_GCX); bf16_t* Yb = (bf16_t*)(BIG + C_Y);
            _Pragma("unroll 1") for (int rep_ = 0; rep_ < (RUN() ? REP_7 : 0); ++rep_) { PHASE_IDS();
                pg8::Gemm g{XB, (const bf16_t*)(ws + W_CWIN), M, 3 * D, D}; pg8::StaticOrder S; S.init(M, 3 * D, G_, bx);
                pg8::EpiAct<3> E{GCX, 3 * D, 0, 0, SSP, nullptr};
                pg8::gemm_phase<pg8::EpiAct<3>, pg8::StaticOrder>(lds, g, S, E);
            }
            SEAM();
            _Pragma("unroll 1") for (int rep_ = 0; rep_ < (RUN() ? REP_8 : 0); ++rep_) { PHASE_IDS();
                const float* cw = args.in[19];
                for (int id = gtid; id < (M / 16) * 128; id += NGT) {
                    const int cgp = id & 127, r = id >> 7, c0 = 8 * cgp, rowb = r * 16;
                    f32x4 w[3][2];
#pragma unroll
                    for (int k = 0; k < 3; ++k) { w[k][0] = *(const f32x4*)(cw + k * D + c0); w[k][1] = *(const f32x4*)(cw + k * D + c0 + 4); }
                    float p2[8], p1[8];
#pragma unroll
                    for (int jj = 0; jj < 8; ++jj) { p2[jj] = 0.f; p1[jj] = 0.f; }
                    if ((rowb & (SEQ - 1)) != 0) {
                        const u32x4 ga = *(const u32x4*)(GCX + (size_t)(rowb - 2) * 3 * D + D + c0), xa = *(const u32x4*)(GCX + (size_t)(rowb - 2) * 3 * D + 2 * D + c0);
                        const u32x4 gb_ = *(const u32x4*)(GCX + (size_t)(rowb - 1) * 3 * D + D + c0), xb_ = *(const u32x4*)(GCX + (size_t)(rowb - 1) * 3 * D + 2 * D + c0);
                        p2[0] = bf_lo(ga.x) * bf_lo(xa.x); p2[1] = bf_hi(ga.x) * bf_hi(xa.x); p2[2] = bf_lo(ga.y) * bf_lo(xa.y); p2[3] = bf_hi(ga.y) * bf_hi(xa.y);
                        p2[4] = bf_lo(ga.z) * bf_lo(xa.z); p2[5] = bf_hi(ga.z) * bf_hi(xa.z); p2[6] = bf_lo(ga.w) * bf_lo(xa.w); p2[7] = bf_hi(ga.w) * bf_hi(xa.w);
                        p1[0] = bf_lo(gb_.x) * bf_lo(xb_.x); p1[1] = bf_hi(gb_.x) * bf_hi(xb_.x); p1[2] = bf_lo(gb_.y) * bf_lo(xb_.y); p1[3] = bf_hi(gb_.y) * bf_hi(xb_.y);
                        p1[4] = bf_lo(gb_.z) * bf_lo(xb_.z); p1[5] = bf_hi(gb_.z) * bf_hi(xb_.z); p1[6] = bf_lo(gb_.w) * bf_lo(xb_.w); p1[7] = bf_hi(gb_.w) * bf_hi(xb_.w);
                    }
#pragma unroll 4
                    for (int t = 0; t < 16; ++t) {
                        const size_t ro = (size_t)(rowb + t) * 3 * D + c0;
                        const u32x4 bb = *(const u32x4*)(GCX + ro), gc = *(const u32x4*)(GCX + ro + D), xv = *(const u32x4*)(GCX + ro + 2 * D);
                        float p0[8], gbv[8];
                        p0[0] = bf_lo(gc.x) * bf_lo(xv.x); p0[1] = bf_hi(gc.x) * bf_hi(xv.x); p0[2] = bf_lo(gc.y) * bf_lo(xv.y); p0[3] = bf_hi(gc.y) * bf_hi(xv.y);
                        p0[4] = bf_lo(gc.z) * bf_lo(xv.z); p0[5] = bf_hi(gc.z) * bf_hi(xv.z); p0[6] = bf_lo(gc.w) * bf_lo(xv.w); p0[7] = bf_hi(gc.w) * bf_hi(xv.w);
                        gbv[0] = bf_lo(bb.x); gbv[1] = bf_hi(bb.x); gbv[2] = bf_lo(bb.y); gbv[3] = bf_hi(bb.y); gbv[4] = bf_lo(bb.z); gbv[5] = bf_hi(bb.z); gbv[6] = bf_lo(bb.w); gbv[7] = bf_hi(bb.w);
                        float y[8];
#pragma unroll
                        for (int jj = 0; jj < 8; ++jj) { y[jj] = gbv[jj] * (w[0][jj >> 2][jj & 3] * p2[jj] + w[1][jj >> 2][jj & 3] * p1[jj] + w[2][jj >> 2][jj & 3] * p0[jj]); p2[jj] = p1[jj]; p1[jj] = p0[jj]; }
                        u32x4 o; o.x = cvt_pk_bf16(y[0], y[1]); o.y = cvt_pk_bf16(y[2], y[3]); o.z = cvt_pk_bf16(y[4], y[5]); o.w = cvt_pk_bf16(y[6], y[7]);
                        *(u32x4*)(Yb + (size_t)(rowb + t) * D + c0) = o;
                    }
                }
            }
            SEAM();
            Ymix = Yb; Wout = (const bf16_t*)(ws + W_CWOUT); Kout = D;
        }
        _Pragma("unroll 1") for (int rep_ = 0; rep_ < (RUN() ? REP_9 : 0); ++rep_) { PHASE_IDS();
            pg8::Gemm g{Ymix, Wout, M, D, Kout}; pg8::StaticOrder S; S.init(M, D, G_, bx);
            pg8::EpiRes E{XB, SSP};
            pg8::gemm_phase<pg8::EpiRes, pg8::StaticOrder>(lds, g, S, E);
        }
        SEAM();
        _Pragma("unroll 1") for (int rep_ = 0; rep_ < (RUN() ? REP_10 : 0); ++rep_) { PHASE_IDS();
            pg8::Gemm g{XB, (const bf16_t*)(ws + W_W1) + (size_t)L * D * FF, M, FF, D}; pg8::StaticOrder S; S.init(M, FF, G_, bx);
            pg8::EpiAct<1> E{(bf16_t*)BIG, FF, 0, 0, SSP, nullptr};
            pg8::gemm_phase<pg8::EpiAct<1>, pg8::StaticOrder>(lds, g, S, E);
        }
        SEAM();
        _Pragma("unroll 1") for (int rep_ = 0; rep_ < (RUN() ? REP_11 : 0); ++rep_) { PHASE_IDS();
            pg8::Gemm g{(const bf16_t*)BIG, (const bf16_t*)(ws + W_W2) + (size_t)L * FF * D, M, D, FF}; pg8::StaticOrder S; S.init(M, D, G_, bx);
            pg8::EpiRes E{XB, SSP};
            pg8::gemm_phase<pg8::EpiRes, pg8::StaticOrder>(lds, g, S, E);
        }
        SEAM();
    }
    _Pragma("unroll 1") for (int rep_ = 0; rep_ < (RUN() ? REP_12 : 0); ++rep_) { PHASE_IDS();
        const float* fg = args.in[3];
        for (int r = gw; r < M; r += NGW) {
            float s = (lane < 16) ? SSP[(size_t)r * 16 + lane] : 0.f;
            s = wave_sum(s);
            const float rs = __builtin_amdgcn_rsqf(s * (1.0f / 1024.0f) + EPS);
            const u32x4* xr = (const u32x4*)(XB + (size_t)r * D) + lane; const f32x4* gr = (const f32x4*)fg + 2 * lane; f32x4* orow = (f32x4*)(X + (size_t)r * D) + 2 * lane;
#pragma unroll
            for (int jj = 0; jj < 2; ++jj) { const u32x4 v = xr[64 * jj]; const f32x4 g0 = gr[128 * jj], g1 = gr[128 * jj + 1];
                f32x4 o0, o1; o0[0] = bf_lo(v.x) * rs * g0[0]; o0[1] = bf_hi(v.x) * rs * g0[1]; o0[2] = bf_lo(v.y) * rs * g0[2]; o0[3] = bf_hi(v.y) * rs * g0[3];
                o1[0] = bf_lo(v.z) * rs * g1[0]; o1[1] = bf_hi(v.z) * rs * g1[1]; o1[2] = bf_lo(v.w) * rs * g1[2]; o1[3] = bf_hi(v.w) * rs * g1[3];
                __builtin_nontemporal_store(o0, orow + 128 * jj); __builtin_nontemporal_store(o1, orow + 128 * jj + 1); }
        }
    }
#undef RUN
#undef SEAM
}

extern "C" void kernel_launch(void* const* d_in, const int* in_sizes, int n_in, void* d_out, int out_size, void* d_ws, size_t ws_size, hipStream_t stream) {
    static int grid = 0;
    if (grid == 0) {
        if (n_in != 23 || in_sizes[0] != M * D || out_size != M * D || ws_size < WS_END) {
            fprintf(stderr, "kernel_launch: unexpected shapes (n_in %d, in0 %d, out %d, ws %zu < %zu); nothing launched\n", n_in, n_in > 0 ? in_sizes[0] : -1, out_size, ws_size, (size_t)WS_END); grid = -1; return; }
        int dev = 0, cus = 0, per_cu = 0;
        if (hipGetDevice(&dev) != hipSuccess || hipDeviceGetAttribute(&cus, hipDeviceAttributeMultiprocessorCount, dev) != hipSuccess) { grid = -1; return; }
        if (hipFuncSetAttribute((const void*)trunk_fwd, hipFuncAttributeMaxDynamicSharedMemorySize, LDS_BYTES) != hipSuccess) { fprintf(stderr, "kernel_launch: hipFuncSetAttribute failed\n"); grid = -1; return; }
        if (hipOccupancyMaxActiveBlocksPerMultiprocessor(&per_cu, (const void*)trunk_fwd, 512, LDS_BYTES) != hipSuccess || per_cu < 1) { fprintf(stderr, "kernel_launch: occupancy query gave %d\n", per_cu); per_cu = 1; }
        (void)hipGetLastError();
        grid = cus * per_cu;
    }
    if (grid < 0) return;
    Args a{};
    for (int i = 0; i < 23; ++i) a.in[i] = (const float*)d_in[i];
    a.out = (float*)d_out; a.ws = (unsigned char*)d_ws;
#if MK_MULTI
    for (int p = 0; p < NPHASE; ++p) { a.lo = p; a.hi = p + 1; hipLaunchKernelGGL(trunk_fwd, dim3(grid), dim3(512), LDS_BYTES, stream, a); }
#else
    a.lo = 0; a.hi = NPHASE;
    void* kargs[] = {(void*)&a};
    hipError_t e = hipLaunchCooperativeKernel((const void*)trunk_fwd, dim3(grid), dim3(512), kargs, LDS_BYTES, stream);
    if (e != hipSuccess) fprintf(stderr, "kernel_launch: cooperative launch failed: %s (grid %d)\n", hipGetErrorString(e), grid);
#endif
}
```

```cpp
#include <hip/hip_runtime.h>
#include <hip/hip_cooperative_groups.h>
#include <cstdio>
#include <cstdint>
namespace cg = cooperative_groups;

#ifndef PHMASK
#define PHMASK 0xFFFFFFFFu
#endif
#ifndef REP_0
#define REP_0 1
#endif
#ifndef REP_1
#define REP_1 1
#endif
#ifndef REP_2
#define REP_2 1
#endif
#ifndef REP_3
#define REP_3 1
#endif
#ifndef REP_4
#define REP_4 1
#endif
#ifndef REP_5
#define REP_5 1
#endif
#ifndef REP_6
#define REP_6 1
#endif
#ifndef REP_7
#define REP_7 1
#endif
#ifndef REP_8
#define REP_8 1
#endif
#ifndef REP_9
#define REP_9 1
#endif
#ifndef REP_10
#define REP_10 1
#endif
#ifndef REP_11
#define REP_11 1
#endif
#ifndef REP_12
#define REP_12 1
#endif
#ifndef MK_MULTI
#define MK_MULTI 0
#endif

#define LAS __attribute__((address_space(3)))
typedef unsigned short bf16_t;
typedef short bf16x8 __attribute__((ext_vector_type(8)));
typedef float f32x4 __attribute__((ext_vector_type(4)));
typedef float f32x2 __attribute__((ext_vector_type(2)));
typedef unsigned u32x4 __attribute__((ext_vector_type(4)));
typedef unsigned u32x2 __attribute__((ext_vector_type(2)));

constexpr int SEQ = 8192, M = 2 * SEQ, D = 1024, DR = 1280, FF = 4096, NH = 16, HD = 80;
constexpr float EPS = 1e-6f, LOG2E = 1.4426950408889634f;
constexpr int NPHASE = 24;

constexpr size_t MiB = 1u << 20;
constexpr size_t WS_SSP = 0;
constexpr size_t WS_GW = 1 * MiB;
constexpr size_t WS_BAR = 1 * MiB + 983040;
constexpr size_t WS_WSB = 2 * MiB;
constexpr size_t WS_W = 2 * MiB + 256 * 1024;
constexpr size_t W_AWIN = WS_W, W_AWOUT = WS_W + 10 * MiB, W_BWIN = WS_W + 15 * MiB, W_BWOUT = WS_W + 19 * MiB, W_CWIN = WS_W + 21 * MiB,
                 W_CWOUT = WS_W + 27 * MiB, W_W1 = WS_W + 29 * MiB, W_W2 = WS_W + 61 * MiB;
constexpr size_t WS_XB = WS_W + 93 * MiB;
constexpr size_t WS_BIG = WS_XB + 32 * MiB;
constexpr size_t WS_END = WS_BIG + 128 * MiB;
constexpr size_t A_G = 0, A_XR = 40 * MiB, A_Y = 80 * MiB, A_AGG = 120 * MiB, A_CARRY = 124 * MiB;
constexpr size_t B_U = 0, B_V = 32 * MiB, B_Y = 64 * MiB, B_SSV = 96 * MiB;
constexpr size_t C_GCX = 0, C_Y = 96 * MiB;

constexpr int LDS_BYTES = 147456;

namespace pg8 {
constexpr int BM = 256, BK = 64, HALF = 128, HTB = HALF * BK * 2, STAGE_BYTES = 8 * HTB, NXCD = 8, WGM = 8;
__host__ __device__ __forceinline__ int lds_byte(int r, int c) { const int st = (r >> 4) * 2 + (c >> 5), rr = r & 15, cc = c & 31, ob = rr * 64 + cc * 2; return st * 1024 + (ob ^ (((ob >> 9) & 1) << 5)); }
__host__ __device__ __forceinline__ void stage_rc(int b, int& R, int& C) { const int st = b / 1024, sb = b % 1024, swz = sb ^ (((sb >> 9) & 1) << 5); R = (st >> 1) * 16 + swz / 64; C = (st & 1) * 32 + (swz % 64) / 2; }
__host__ __device__ __forceinline__ int perm32(int rho) { const int n = rho >> 4, i = rho & 15; return 8 * (i >> 2) + 4 * n + (i & 3); }

struct Unit { int pm, pn; };
struct Gemm { const bf16_t* A; const bf16_t* Bt; int M, N, K; };

struct StaticOrder {
    int nM, nN, nwg, G, c;
    __host__ __device__ void init(int M_, int N_, int G_, int c_) { nM = M_ / BM; nN = N_ / BM; nwg = nM * nN; G = G_; c = c_; }
    __host__ __device__ bool next(int i, Unit& u) const {
        const long L = (long)i * G + c; if (L >= nwg) return false;
        int wgid = (int)L; { const int q = nwg / NXCD, r = nwg % NXCD, xcd = wgid % NXCD, off = wgid / NXCD; wgid = (xcd < r ? xcd * (q + 1) : r * (q + 1) + (xcd - r) * q) + off; }
        const int nig = WGM * nN, gid = wgid / nig, fm = gid * WGM, gsz = (nM - fm) < WGM ? (nM - fm) : WGM;
        u.pm = fm + ((wgid % nig) % gsz); u.pn = (wgid % nig) / gsz; return true;
    }
};

__device__ __forceinline__ unsigned cvt_pk_bf16(float lo, float hi) { unsigned r; asm volatile("v_cvt_pk_bf16_f32 %0, %1, %2" : "=v"(r) : "v"(lo), "v"(hi)); return r; }
__device__ __forceinline__ float fast_rcp(float x) { return __builtin_amdgcn_rcpf(x); }
__device__ __forceinline__ float fast_exp2(float x) { return __builtin_amdgcn_exp2f(x); }
__device__ __forceinline__ float sigmoidf_(float z) { return fast_rcp(1.0f + fast_exp2(-LOG2E * z)); }
__device__ __forceinline__ float gelu_tanh(float x) { const float z = x * (1.0f + 0.044715f * x * x); return x * fast_rcp(1.0f + fast_exp2(-2.0f * 0.7978845608028654f * LOG2E * z)); }

__device__ __forceinline__ float row_rs(const float* ssp, int row, int fq) {
    const f32x4 p = *(const f32x4*)(ssp + (size_t)row * 16 + 4 * fq);
    float s = (p[0] + p[1]) + (p[2] + p[3]);
    s += __shfl_xor(s, 16); s += __shfl_xor(s, 32);
    return __builtin_amdgcn_rsqf(s * (1.0f / 1024.0f) + EPS);
}

template <int MODE> struct EpiAct {
    static constexpr bool PERM = true, AFTER_DRAIN = false;
    bf16_t* O; int ldc; int split_cols; size_t split_stride; const float* ssp; float* ssv;
    __device__ __forceinline__ void operator()(const f32x4 (&acc)[2][2][4][2], const Unit& u, int wr, int wc, int fr, int fq) const {
        const int row0 = u.pm * BM + wr * 64 + fr; int colt = u.pn * BM; bf16_t* base = O; int t = 0;
        if (split_cols) { t = colt / split_cols; base += (size_t)t * split_stride; colt -= t * split_cols; }
        const int col0 = colt + wc * 32 + 8 * fq;
#pragma unroll
        for (int ai = 0; ai < 2; ++ai)
#pragma unroll
            for (int m = 0; m < 4; ++m) {
                const int row = row0 + ai * HALF + m * 16;
                const float rs = row_rs(ssp, row, fq);
                bf16_t* rowp = base + (size_t)row * ldc + col0; float vs = 0.f;
#pragma unroll
                for (int bj = 0; bj < 2; ++bj) {
                    f32x4 v0 = acc[ai][bj][m][0] * rs, v1 = acc[ai][bj][m][1] * rs;
                    if (MODE == 0) { if (t == 0) {
#pragma unroll
                        for (int j = 0; j < 4; ++j) { v0[j] = gelu_tanh(v0[j]); v1[j] = gelu_tanh(v1[j]); } } }
                    if (MODE == 1) {
#pragma unroll
                        for (int j = 0; j < 4; ++j) { const float a = fmaxf(v0[j], 0.f), b = fmaxf(v1[j], 0.f); v0[j] = a * a; v1[j] = b * b; } }
                    if (MODE == 2) {
#pragma unroll
                        for (int j = 0; j < 4; ++j) { v0[j] = gelu_tanh(v0[j]); v1[j] = gelu_tanh(v1[j]); }
                        vs += (v0[0] * v0[0] + v0[1] * v0[1]) + (v0[2] * v0[2] + v0[3] * v0[3]) + (v1[0] * v1[0] + v1[1] * v1[1]) + (v1[2] * v1[2] + v1[3] * v1[3]); }
                    u32x4 w; w.x = cvt_pk_bf16(v0[0], v0[1]); w.y = cvt_pk_bf16(v0[2], v0[3]); w.z = cvt_pk_bf16(v1[0], v1[1]); w.w = cvt_pk_bf16(v1[2], v1[3]);
                    *(u32x4*)(rowp + bj * HALF) = w;
                }
                if (MODE == 2) { vs += __shfl_xor(vs, 16); vs += __shfl_xor(vs, 32);
                    if (t == 1 && fq == 0) ssv[(size_t)row * 16 + (u.pn - 4) * 4 + wc] = vs; }
            }
    }
};
struct EpiRes {
    static constexpr bool PERM = true, AFTER_DRAIN = false;
    bf16_t* xb; float* ssp;
    __device__ __forceinline__ void operator()(const f32x4 (&acc)[2][2][4][2], const Unit& u, int wr, int wc, int fr, int fq) const {
        const int row0 = u.pm * BM + wr * 64 + fr, col0 = u.pn * BM + wc * 32 + 8 * fq;
#pragma unroll
        for (int ai = 0; ai < 2; ++ai)
#pragma unroll
            for (int m = 0; m < 4; ++m) {
                const int row = row0 + ai * HALF + m * 16; float ss = 0.f;
#pragma unroll
                for (int bj = 0; bj < 2; ++bj) {
                    const size_t off = (size_t)row * D + col0 + bj * HALF;
                    const u32x4 b = *(const u32x4*)(xb + off);
                    const f32x4 a0 = acc[ai][bj][m][0], a1 = acc[ai][bj][m][1];
                    u32x4 w;
                    w.x = cvt_pk_bf16(a0[0] + __uint_as_float(b.x << 16), a0[1] + __uint_as_float(b.x & 0xffff0000u));
                    w.y = cvt_pk_bf16(a0[2] + __uint_as_float(b.y << 16), a0[3] + __uint_as_float(b.y & 0xffff0000u));
                    w.z = cvt_pk_bf16(a1[0] + __uint_as_float(b.z << 16), a1[1] + __uint_as_float(b.z & 0xffff0000u));
                    w.w = cvt_pk_bf16(a1[2] + __uint_as_float(b.w << 16), a1[3] + __uint_as_float(b.w & 0xffff0000u));
                    *(u32x4*)(xb + off) = w;
                    const float r0 = __uint_as_float(w.x << 16), r1 = __uint_as_float(w.x & 0xffff0000u), r2 = __uint_as_float(w.y << 16), r3 = __uint_as_float(w.y & 0xffff0000u);
                    const float r4 = __uint_as_float(w.z << 16), r5 = __uint_as_float(w.z & 0xffff0000u), r6 = __uint_as_float(w.w << 16), r7 = __uint_as_float(w.w & 0xffff0000u);
                    ss += (r0 * r0 + r1 * r1) + (r2 * r2 + r3 * r3) + (r4 * r4 + r5 * r5) + (r6 * r6 + r7 * r7);
                }
                ss += __shfl_xor(ss, 16); ss += __shfl_xor(ss, 32);
                if (fq == 0) ssp[(size_t)row * 16 + u.pn * 4 + wc] = ss;
            }
    }
};

template <class Epi, class Sched, bool ALIGN_EPI = true>
__device__ __forceinline__ void gemm_phase(LAS unsigned char* lds, const Gemm g, const Sched& S, const Epi& E) {
    int tid_o = threadIdx.x; asm volatile("" : "+v"(tid_o));
    const int tid = tid_o, wid = __builtin_amdgcn_readfirstlane(tid >> 6), lane = tid & 63, wr = wid >> 2, wc = wid & 3, fr = lane & 15, fq = lane >> 4;
    const int K = g.K, nt = K / BK;
    unsigned voffA[2], voffB[2];
#pragma unroll
    for (int i = 0; i < 2; ++i) { int R, C; stage_rc(tid * 16 + i * 8192, R, C); const int Rb = Epi::PERM ? ((R & ~31) + perm32(R & 31)) : R;
        voffA[i] = (unsigned)(R * K + C) * 2u; voffB[i] = (unsigned)(Rb * K + C) * 2u; }
    const size_t kstep = (size_t)(BK * 2);
    const size_t hstep = (size_t)HALF * K * 2;
    const size_t tstep = 2 * hstep;
    const unsigned ldsw = (unsigned)wid * 1024u;
    const int aoff = lds_byte(wr * 64 + fr, fq * 8), boff = lds_byte(wc * 32 + fr, fq * 8);
#define PG8_SA(b, h) (((b) * 2 + (h)) * HTB)
#define PG8_SB(b, h) ((4 + (b) * 2 + (h)) * HTB)
#define PG8_STAGE(bufoff, gbase, voff) do { _Pragma("unroll") for (int _i = 0; _i < 2; ++_i) \
        __builtin_amdgcn_global_load_lds((const unsigned*)((const char*)(gbase) + (voff)[_i]), (LAS unsigned*)(lds + (bufoff) + ldsw + _i * 8192), 16, 0, 0); } while (0)
#define PG8_LDA(dst, b, h) do { _Pragma("unroll") for (int m = 0; m < 4; ++m) _Pragma("unroll") for (int k = 0; k < 2; ++k) dst[m][k] = *(const LAS bf16x8*)(lds + PG8_SA(b, h) + aoff + m * 2048 + k * 1024); } while (0)
#define PG8_LDB(dst, b, h) do { _Pragma("unroll") for (int n = 0; n < 2; ++n) _Pragma("unroll") for (int k = 0; k < 2; ++k) dst[n][k] = *(const LAS bf16x8*)(lds + PG8_SB(b, h) + boff + n * 2048 + k * 1024); } while (0)
#define PG8_MMA(ai, bj, At, Bt) do { __builtin_amdgcn_s_setprio(1); _Pragma("unroll") for (int m = 0; m < 4; ++m) _Pragma("unroll") for (int n = 0; n < 2; ++n) _Pragma("unroll") for (int k = 0; k < 2; ++k) \
        acc[ai][bj][m][n] = __builtin_amdgcn_mfma_f32_16x16x32_bf16(Bt[n][k], At[m][k], acc[ai][bj][m][n], 0, 0, 0); __builtin_amdgcn_s_setprio(0); } while (0)
#define PG8_WAIT_V(n) asm volatile("s_waitcnt vmcnt(" #n ")" ::: "memory")
#define PG8_WAIT_L(n) asm volatile("s_waitcnt lgkmcnt(" #n ")" ::: "memory")
#define PG8_BAR __builtin_amdgcn_s_barrier()
#define PG8_SCHED __builtin_amdgcn_sched_barrier(0)
    Unit cur, nxt; int ui = 0;
    if (!S.next(0, cur)) return;
    f32x4 acc[2][2][4][2];
#pragma unroll
    for (int a = 0; a < 2; ++a)
#pragma unroll
        for (int b = 0; b < 2; ++b)
#pragma unroll
            for (int m = 0; m < 4; ++m)
#pragma unroll
                for (int n = 0; n < 2; ++n) acc[a][b][m][n] = (f32x4){0.f, 0.f, 0.f, 0.f};
    bf16x8 At[4][2], B0[2][2], B1[2][2];
    const char* cA = (const char*)g.A + (size_t)cur.pm * tstep; const char* cB = (const char*)g.Bt + (size_t)cur.pn * tstep;
    PG8_STAGE(PG8_SB(0, 0), cB, voffB); PG8_STAGE(PG8_SB(0, 1), cB + hstep, voffB); PG8_STAGE(PG8_SA(0, 0), cA, voffA); PG8_STAGE(PG8_SA(0, 1), cA + hstep, voffA);
    if (wr == 1) PG8_BAR;
    PG8_WAIT_V(2); PG8_BAR;
    PG8_STAGE(PG8_SB(1, 0), cB + kstep, voffB); PG8_STAGE(PG8_SA(1, 0), cA + kstep, voffA); PG8_STAGE(PG8_SB(1, 1), cB + hstep + kstep, voffB);
    PG8_WAIT_V(6); PG8_BAR;
    for (;;) {
        const bool has_next = S.next(ui + 1, nxt);
        const char* nA = has_next ? (const char*)g.A + (size_t)nxt.pm * tstep : cA; const char* nB = has_next ? (const char*)g.Bt + (size_t)nxt.pn * tstep : cB;
        for (int t = 0; t < nt; t += 2) {
            const bool last = (t == nt - 2);
            const char* a1 = cA + (size_t)(t + 1) * kstep;
            const char* a2 = last ? nA : cA + (size_t)(t + 2) * kstep; const char* b2 = last ? nB : cB + (size_t)(t + 2) * kstep;
            const char* a3 = a2 + kstep; const char* b3 = b2 + kstep;
            PG8_LDB(B0, 0, 0); PG8_LDB(B1, 0, 1); PG8_SCHED; PG8_LDA(At, 0, 0); PG8_STAGE(PG8_SA(1, 1), a1 + hstep, voffA);
            PG8_WAIT_V(8); PG8_WAIT_L(0); PG8_BAR; PG8_MMA(0, 0, At, B0); PG8_MMA(0, 1, At, B1); PG8_BAR; PG8_SCHED;
            PG8_LDA(At, 0, 1); PG8_STAGE(PG8_SB(0, 0), b2, voffB); PG8_STAGE(PG8_SB(0, 1), b2 + hstep, voffB); PG8_STAGE(PG8_SA(0, 0), a2, voffA);
            PG8_WAIT_V(8); PG8_WAIT_L(0); PG8_BAR; PG8_MMA(1, 0, At, B0); PG8_MMA(1, 1, At, B1); PG8_BAR; PG8_SCHED;
            PG8_LDB(B0, 1, 0); PG8_LDB(B1, 1, 1); PG8_SCHED; PG8_LDA(At, 1, 0); PG8_STAGE(PG8_SA(0, 1), a2 + hstep, voffA);
            PG8_WAIT_V(8); PG8_WAIT_L(0); PG8_BAR; PG8_MMA(0, 0, At, B0); PG8_MMA(0, 1, At, B1); PG8_BAR; PG8_SCHED;
            PG8_LDA(At, 1, 1); PG8_STAGE(PG8_SB(1, 0), b3, voffB); PG8_STAGE(PG8_SB(1, 1), b3 + hstep, voffB); PG8_STAGE(PG8_SA(1, 0), a3, voffA);
            PG8_WAIT_V(8); PG8_WAIT_L(0); PG8_BAR; PG8_MMA(1, 0, At, B0); PG8_MMA(1, 1, At, B1); PG8_BAR; PG8_SCHED;
        }
        if constexpr (ALIGN_EPI) { if (wr == 0) PG8_BAR; }
        E(acc, cur, wr, wc, fr, fq);
        if (!has_next) break;
#pragma unroll
        for (int a = 0; a < 2; ++a)
#pragma unroll
            for (int b = 0; b < 2; ++b)
#pragma unroll
                for (int m = 0; m < 4; ++m)
#pragma unroll
                    for (int n = 0; n < 2; ++n) acc[a][b][m][n] = (f32x4){0.f, 0.f, 0.f, 0.f};
        cur = nxt; cA = nA; cB = nB; ++ui;
        if constexpr (ALIGN_EPI) { if (wr == 1) PG8_BAR; }
    }
    PG8_WAIT_V(0);
    if constexpr (!ALIGN_EPI) { if (wr == 0) PG8_BAR; }
    PG8_BAR;
#undef PG8_SA
#undef PG8_SB
#undef PG8_STAGE
#undef PG8_LDA
#undef PG8_LDB
#undef PG8_MMA
#undef PG8_WAIT_V
#undef PG8_WAIT_L
#undef PG8_BAR
#undef PG8_SCHED
}
}
using pg8::cvt_pk_bf16;

__device__ __forceinline__ float bf_lo(unsigned w) { return __uint_as_float(w << 16); }
__device__ __forceinline__ float bf_hi(unsigned w) { return __uint_as_float(w & 0xffff0000u); }
__device__ __forceinline__ float wave_sum(float v) {
#pragma unroll
    for (int o = 1; o < 64; o <<= 1) v += __shfl_xor(v, o);
    return v;
}
#define LDS_WAIT() asm volatile("s_waitcnt lgkmcnt(0)" ::: "memory")

struct Args { const float* in[23]; float* out; unsigned char* ws; int lo, hi; };

struct P0Item { const float* W; const float* gain; bf16_t* WT; int K, N, k0, n0; };
__device__ __forceinline__ P0Item p0_decode(const Args& a, unsigned char* ws, int it) {
    P0Item d; d.gain = nullptr; int r = it;
    if (r < 2560)        { const int j = r / 1280; r -= j * 1280; d.W = a.in[4] + (size_t)j * D * 2 * DR; d.gain = a.in[1] + (size_t)(3 * j) * D; d.WT = (bf16_t*)(ws + W_AWIN) + (size_t)j * D * 2 * DR; d.K = D; d.N = 2 * DR; }
    else if (r < 3840)   { r -= 2560; const int j = r / 640; r -= j * 640; d.W = a.in[12] + (size_t)j * DR * D; d.WT = (bf16_t*)(ws + W_AWOUT) + (size_t)j * DR * D; d.K = DR; d.N = D; }
    else if (r < 4864)   { r -= 3840; d.W = a.in[13]; d.gain = a.in[1] + 1 * D; d.WT = (bf16_t*)(ws + W_BWIN); d.K = D; d.N = 2 * D; }
    else if (r < 5376)   { r -= 4864; d.W = a.in[17]; d.WT = (bf16_t*)(ws + W_BWOUT); d.K = D; d.N = D; }
    else if (r < 6912)   { r -= 5376; d.W = a.in[18]; d.gain = a.in[1] + 2 * D; d.WT = (bf16_t*)(ws + W_CWIN); d.K = D; d.N = 3 * D; }
    else if (r < 7424)   { r -= 6912; d.W = a.in[20]; d.WT = (bf16_t*)(ws + W_CWOUT); d.K = D; d.N = D; }
    else if (r < 15616)  { r -= 7424; const int i = r >> 11; r &= 2047; d.W = a.in[21] + (size_t)i * D * FF; d.gain = a.in[2] + (size_t)i * D; d.WT = (bf16_t*)(ws + W_W1) + (size_t)i * D * FF; d.K = D; d.N = FF; }
    else                 { r -= 15616; const int i = r >> 11; r &= 2047; d.W = a.in[22] + (size_t)i * FF * D; d.WT = (bf16_t*)(ws + W_W2) + (size_t)i * FF * D; d.K = FF; d.N = D; }
    const int nblk = d.N / 32; d.k0 = 64 * (r / nblk); d.n0 = 32 * (r % nblk);
    return d;
}
constexpr int P0_NITEMS = 23808;
__device__ __forceinline__ void p0_load(const P0Item& d, int lane, f32x4 (&R)[8]) {
    const float* p = d.W + (size_t)(d.k0 + (lane >> 3)) * d.N + d.n0 + 4 * (lane & 7);
#pragma unroll
    for (int i = 0; i < 8; ++i) R[i] = __builtin_nontemporal_load((const f32x4*)(p + (size_t)(8 * i) * d.N));
}
__device__ __forceinline__ void p0_store(const P0Item& d, int lane, const f32x4 (&R)[8], LAS float* scr) {
#pragma unroll
    for (int i = 0; i < 8; ++i) { const int kk = 8 * i + (lane >> 3); const float gk = d.gain ? d.gain[d.k0 + kk] : 1.0f; LAS float* s = scr + kk * 33 + 4 * (lane & 7);
        s[0] = R[i][0] * gk; s[1] = R[i][1] * gk; s[2] = R[i][2] * gk; s[3] = R[i][3] * gk; }
    LDS_WAIT(); asm volatile("" ::: "memory");
    const int c = lane & 7;
#pragma unroll
    for (int j = 0; j < 4; ++j) { const int n = (lane >> 3) + 8 * j; const LAS float* s = scr + (8 * c) * 33 + n;
        u32x4 o; o.x = cvt_pk_bf16(s[0 * 33], s[1 * 33]); o.y = cvt_pk_bf16(s[2 * 33], s[3 * 33]); o.z = cvt_pk_bf16(s[4 * 33], s[5 * 33]); o.w = cvt_pk_bf16(s[6 * 33], s[7 * 33]);
        *(u32x4*)(d.WT + (size_t)(d.n0 + n) * d.K + d.k0 + 8 * c) = o; }
    LDS_WAIT(); asm volatile("" ::: "memory");
}

namespace amid {
constexpr int GWS = 104;
constexpr int OFF_GW = 0, OFF_CONST = 160 * GWS * 2  , OFF_CARRY = OFF_CONST + 8 * 80 * 4, OFF_SEG = OFF_CARRY + 16 * 80 * 4, OFF_WAVE = 45056, WAVE_BYTES = 10880;
static_assert(OFF_SEG + 6 * 80 * 2 * 4 <= OFF_WAVE && OFF_WAVE + 8 * WAVE_BYTES <= 131072 + 1024, "amid LDS map");
}
template <bool PASS2>
__device__ __forceinline__ void a_block(LAS unsigned char* lds, int bu, int tid, int lane, int wave, const bf16_t* XR, const bf16_t* G, bf16_t* Y, float* AGG,
                                        const float* conv_w, const float* conv_b, const bf16_t* GW, const float* ga_b, const float* gx_b, const float* lam) {
    using namespace amid;
    const int h = bu & 15, gI = bu >> 4;
    LAS float* CST = (LAS float*)(lds + OFF_CONST);
    LAS float* CAR = (LAS float*)(lds + OFF_CARRY);
    for (int i = tid; i < 160 * 12; i += 512) { const int row = i / 12, ch = i % 12;
        *(LAS u32x4*)(lds + OFF_GW + row * (GWS * 2) + ch * 16) = *(const u32x4*)(GW + ((size_t)(h * 160 + row)) * 96 + ch * 8); }
    if (tid < 80) { const int c = HD * h + tid;
        CST[0 * 80 + tid] = ga_b[c]; CST[1 * 80 + tid] = gx_b[c]; CST[2 * 80 + tid] = -8.0f * log1pf(__expf(-lam[c])) * LOG2E;
        CST[3 * 80 + tid] = conv_w[0 * DR + c]; CST[4 * 80 + tid] = conv_w[1 * DR + c]; CST[5 * 80 + tid] = conv_w[2 * DR + c]; CST[6 * 80 + tid] = conv_w[3 * DR + c]; CST[7 * 80 + tid] = conv_b[c]; }
    if (PASS2) {
        const int cf = 16 * gI, cb0 = cf & ~127, nprev = cf - cb0, Ls = (nprev + 5) / 6;
        LAS float* SEG = (LAS float*)(lds + OFF_SEG);
        if (tid < 480) {
            const int c = tid % 80, sg = tid / 80, st0 = cb0 + sg * Ls, en = (st0 + Ls < cf) ? st0 + Ls : cf;
            f32x2 pv[19];
#pragma unroll
            for (int i = 0; i < 19; ++i) { const int idx = st0 + i; pv[i] = (idx < en) ? *(const f32x2*)(AGG + ((size_t)idx * DR + HD * h + c) * 2) : (f32x2){1.f, 0.f}; }
            float P = 1.f, H = 0.f;
#pragma unroll
            for (int i = 0; i < 19; ++i) { H = pv[i][0] * H + pv[i][1]; P *= pv[i][0]; }
            SEG[(sg * 80 + c) * 2] = P; SEG[(sg * 80 + c) * 2 + 1] = H;
        }
        __syncthreads();
        if (tid < 80) {
            f32x2 pv[16];
#pragma unroll
            for (int i = 0; i < 16; ++i) pv[i] = *(const f32x2*)(AGG + ((size_t)(cf + i) * DR + HD * h + tid) * 2);
            float s = 0.f;
#pragma unroll
            for (int sg = 0; sg < 6; ++sg) s = SEG[(sg * 80 + tid) * 2] * s + SEG[(sg * 80 + tid) * 2 + 1];
#pragma unroll
            for (int i = 0; i < 16; ++i) { CAR[i * 80 + tid] = s; s = pv[i][0] * s + pv[i][1]; }
        }
    }
    __syncthreads();
    LAS unsigned char* Rb = lds + OFF_WAVE + wave * WAVE_BYTES;
    const int m = lane & 15, q = lane >> 4;
    const int tl = 16 * (m >> 2) + (m & 3);
#pragma unroll 1
    for (int it = 0; it < 2; ++it) {
        const int cn = 16 * gI + 8 * it + wave, row0 = cn * 64;
        const bool first = (cn & 127) == 0;
        int ln = lane; asm volatile("" : "+v"(ln));
        u32x4 xr[11];
#pragma unroll
        for (int i = 0; i < 11; ++i) { const int id = ln + 64 * i, r = id / 10, ch = id - r * 10;
            xr[i] = (u32x4){0u, 0u, 0u, 0u};
            if (id < 670 && !(first && r < 3)) xr[i] = *(const u32x4*)(XR + (long)(row0 - 3 + r) * DR + HD * h + 8 * ch); }
#pragma unroll
        for (int i = 0; i < 11; ++i) { const int id = ln + 64 * i, r = id / 10, ch = id - r * 10; if (id < 670) *(LAS u32x4*)(Rb + r * 160 + 16 * (r >> 4) + 16 * ch) = xr[i]; }
        asm volatile("s_waitcnt lgkmcnt(0)" ::: "memory");
        bf16x8 Af[4][3];
#pragma unroll
        for (int ks = 0; ks < 3; ++ks) {
            const int kc0 = 32 * ks + 8 * q; const bool kval = kc0 < HD; const int kcl = kval ? kc0 : 0;
            f32x4 w[4][2], bb[2];
#pragma unroll
            for (int k = 0; k < 4; ++k) { w[k][0] = *(const LAS f32x4*)(CST + (3 + k) * 80 + kcl); w[k][1] = *(const LAS f32x4*)(CST + (3 + k) * 80 + kcl + 4); }
            bb[0] = *(const LAS f32x4*)(CST + 7 * 80 + kcl); bb[1] = *(const LAS f32x4*)(CST + 7 * 80 + kcl + 4);
#pragma unroll
            for (int rt = 0; rt < 4; ++rt) {
                f32x4 a0 = bb[0], a1 = bb[1];
#pragma unroll
                for (int k = 0; k < 4; ++k) {
                    const int ri = tl + 4 * rt + k;
                    const u32x4 xv = *(const LAS u32x4*)(Rb + ri * 160 + 16 * (ri >> 4) + 2 * kcl);
                    a0[0] += w[k][0][0] * bf_lo(xv.x); a0[1] += w[k][0][1] * bf_hi(xv.x); a0[2] += w[k][0][2] * bf_lo(xv.y); a0[3] += w[k][0][3] * bf_hi(xv.y);
                    a1[0] += w[k][1][0] * bf_lo(xv.z); a1[1] += w[k][1][1] * bf_hi(xv.z); a1[2] += w[k][1][2] * bf_lo(xv.w); a1[3] += w[k][1][3] * bf_hi(xv.w);
                }
                u32x4 pk; pk.x = cvt_pk_bf16(a0[0], a0[1]); pk.y = cvt_pk_bf16(a0[2], a0[3]); pk.z = cvt_pk_bf16(a1[0], a1[1]); pk.w = cvt_pk_bf16(a1[2], a1[3]);
                if (!kval) pk = (u32x4){0u, 0u, 0u, 0u};
                Af[rt][ks] = __builtin_bit_cast(bf16x8, pk);
            }
        }
        if (PASS2) {
            u32x4 gr[10];
#pragma unroll
            for (int i = 0; i < 10; ++i) { const int id = ln + 64 * i, r = id / 10, ch = id - r * 10; gr[i] = *(const u32x4*)(G + (size_t)(row0 + r) * DR + HD * h + 8 * ch); }
            asm volatile("s_waitcnt lgkmcnt(0)" ::: "memory");
#pragma unroll
            for (int i = 0; i < 10; ++i) { const int id = ln + 64 * i, r = id / 10, ch = id - r * 10; *(LAS u32x4*)(Rb + r * 160 + 32 * (r >> 4) + 16 * ch) = gr[i]; }
            asm volatile("s_waitcnt lgkmcnt(0)" ::: "memory");
        }
#pragma unroll 1
        for (int nt = 0; nt < 5; ++nt) {
            const int cl = 16 * nt + m;
            bf16x8 Ba[3], Bx[3];
#pragma unroll
            for (int ks = 0; ks < 3; ++ks) {
                Ba[ks] = *(const LAS bf16x8*)(lds + OFF_GW + (cl) * (GWS * 2) + (32 * ks + 8 * q) * 2);
                Bx[ks] = *(const LAS bf16x8*)(lds + OFF_GW + (80 + cl) * (GWS * 2) + (32 * ks + 8 * q) * 2);
            }
            const float ba = CST[0 * 80 + cl], bx = CST[1 * 80 + cl], kc = CST[2 * 80 + cl];
            bf16x8 Iq;
#pragma unroll
            for (int j = 0; j < 8; ++j) Iq[j] = (8 * q + j == 16 * (nt & 1) + m) ? (short)0x3F80 : (short)0;
            f32x4 ar[4], ax[4], ac[4];
#pragma unroll
            for (int rt = 0; rt < 4; ++rt) {
                ar[rt] = (f32x4){0.f, 0.f, 0.f, 0.f}; ax[rt] = ar[rt]; ac[rt] = ar[rt];
#pragma unroll
                for (int ks = 0; ks < 3; ++ks) {
                    ar[rt] = __builtin_amdgcn_mfma_f32_16x16x32_bf16(Af[rt][ks], Ba[ks], ar[rt], 0, 0, 0);
                    ax[rt] = __builtin_amdgcn_mfma_f32_16x16x32_bf16(Af[rt][ks], Bx[ks], ax[rt], 0, 0, 0);
                }
                const bf16x8 Asel = (nt < 2) ? Af[rt][0] : ((nt < 4) ? Af[rt][1] : Af[rt][2]);
                ac[rt] = __builtin_amdgcn_mfma_f32_16x16x32_bf16(Asel, Iq, ac[rt], 0, 0, 0);
            }
            float hl = 0.f, ca = 1.f; float hs[16], cs[16];
#pragma unroll
            for (int rt = 0; rt < 4; ++rt)
#pragma unroll
                for (int i = 0; i < 4; ++i) {
                    const float r = pg8::sigmoidf_(ar[rt][i] + ba), ig = pg8::sigmoidf_(ax[rt][i] + bx);
                    const float a = pg8::fast_exp2(r * kc);
                    const float mult = __builtin_amdgcn_sqrtf(fmaxf(1.0f - a * a, 0.f));
                    const float uu = mult * ig * ac[rt][i];
                    hl = a * hl + uu; ca *= a;
                    if (PASS2) { hs[4 * rt + i] = hl; cs[4 * rt + i] = ca; }
                }
            const float A0 = __shfl(ca, m), H0 = __shfl(hl, m), A1 = __shfl(ca, m + 16), H1 = __shfl(hl, m + 16), A2 = __shfl(ca, m + 32), H2 = __shfl(hl, m + 32);
            if (!PASS2) {
                const float A3 = __shfl(ca, m + 48), H3 = __shfl(hl, m + 48);
                float s = H0; s = A1 * s + H1; s = A2 * s + H2; s = A3 * s + H3;
                const float P = (A0 * A1) * (A2 * A3);
                if (q == 0) *(f32x2*)(AGG + ((size_t)cn * DR + HD * h + cl) * 2) = (f32x2){P, s};
            } else {
                const float s0 = CAR[(8 * it + wave) * 80 + cl];
                const float s1 = A0 * s0 + H0, s2 = A1 * s1 + H1, s3 = A2 * s2 + H2;
                const float sq = q == 0 ? s0 : (q == 1 ? s1 : (q == 2 ? s2 : s3));
                LAS bf16_t* gy = (LAS bf16_t*)(Rb + (16 * q) * 160 + 32 * q + 2 * cl);
#pragma unroll
                for (int st = 0; st < 16; ++st) {
                    const float hv = hs[st] + cs[st] * sq;
                    const float gv = __uint_as_float((unsigned)gy[st * 80] << 16);
                    gy[st * 80] = (bf16_t)(cvt_pk_bf16(hv * gv, 0.f) & 0xffffu);
                }
            }
        }
        if (PASS2) {
            asm volatile("s_waitcnt lgkmcnt(0)" ::: "memory");
#pragma unroll
            for (int i = 0; i < 10; ++i) { const int id = ln + 64 * i, r = id / 10, ch = id - r * 10;
                const u32x4 v = *(const LAS u32x4*)(Rb + r * 160 + 32 * (r >> 4) + 16 * ch);
                *(u32x4*)(Y + (size_t)(row0 + r) * DR + HD * h + 8 * ch) = v; }
            asm volatile("s_waitcnt lgkmcnt(0)" ::: "memory");
        }
    }
    __syncthreads();
}

constexpr int LDV = 136;
__device__ __forceinline__ void sgu_unit(LAS unsigned char* lds, int u, int tid, int lane, int wave, const bf16_t* U, const bf16_t* V, bf16_t* Y,
                                         const float* ssv, const float* ng, const bf16_t* WSb, const float* sbias) {
    const int g = u & 7, cn = u >> 3, row0 = cn * 128;
    LAS bf16_t* vt = (LAS bf16_t*)lds;
    {
        const int c0 = 8 * (tid & 15);
        const f32x4 g0 = *(const f32x4*)(ng + g * 128 + c0), g1 = *(const f32x4*)(ng + g * 128 + c0 + 4);
#pragma unroll
        for (int i = 0; i < 2; ++i) {
            const int s = 2 * ((tid >> 4) + 32 * i);
            const u32x4 va = *(const u32x4*)(V + (size_t)(row0 + s) * D + g * 128 + c0), vb = *(const u32x4*)(V + (size_t)(row0 + s + 1) * D + g * 128 + c0);
            float sa = 0.f, sb = 0.f;
#pragma unroll
            for (int k = 0; k < 4; ++k) { const f32x4 pa = *(const f32x4*)(ssv + (size_t)(row0 + s) * 16 + 4 * k), pb = *(const f32x4*)(ssv + (size_t)(row0 + s + 1) * 16 + 4 * k);
                sa += (pa[0] + pa[1]) + (pa[2] + pa[3]); sb += (pb[0] + pb[1]) + (pb[2] + pb[3]); }
            const float ra = __builtin_amdgcn_rsqf(sa * (1.0f / 1024.0f) + EPS), rb = __builtin_amdgcn_rsqf(sb * (1.0f / 1024.0f) + EPS);
            LAS unsigned* dst = (LAS unsigned*)(vt + s);
            dst[(c0 + 0) * (LDV / 2)] = cvt_pk_bf16(bf_lo(va.x) * ra * g0[0], bf_lo(vb.x) * rb * g0[0]);
            dst[(c0 + 1) * (LDV / 2)] = cvt_pk_bf16(bf_hi(va.x) * ra * g0[1], bf_hi(vb.x) * rb * g0[1]);
            dst[(c0 + 2) * (LDV / 2)] = cvt_pk_bf16(bf_lo(va.y) * ra * g0[2], bf_lo(vb.y) * rb * g0[2]);
            dst[(c0 + 3) * (LDV / 2)] = cvt_pk_bf16(bf_hi(va.y) * ra * g0[3], bf_hi(vb.y) * rb * g0[3]);
            dst[(c0 + 4) * (LDV / 2)] = cvt_pk_bf16(bf_lo(va.z) * ra * g1[0], bf_lo(vb.z) * rb * g1[0]);
            dst[(c0 + 5) * (LDV / 2)] = cvt_pk_bf16(bf_hi(va.z) * ra * g1[1], bf_hi(vb.z) * rb * g1[1]);
            dst[(c0 + 6) * (LDV / 2)] = cvt_pk_bf16(bf_lo(va.w) * ra * g1[2], bf_lo(vb.w) * rb * g1[2]);
            dst[(c0 + 7) * (LDV / 2)] = cvt_pk_bf16(bf_hi(va.w) * ra * g1[3], bf_hi(vb.w) * rb * g1[3]);
        }
    }
    __syncthreads();
    {
        const int m = lane & 15, q = lane >> 4, t = 16 * wave + m, kmax = wave >> 1;
        bf16x8 Bw[4];
#pragma unroll
        for (int ks = 0; ks < 4; ++ks) { Bw[ks] = (bf16x8){0, 0, 0, 0, 0, 0, 0, 0}; if (ks <= kmax) Bw[ks] = *(const bf16x8*)(WSb + ((size_t)(g * 128 + t)) * 128 + 32 * ks + 8 * q); }
        const float bias = sbias[g * 128 + t];
#pragma unroll
        for (int p = 0; p < 4; ++p) {
            f32x4 ac[2];
#pragma unroll
            for (int e = 0; e < 2; ++e) {
                ac[e] = (f32x4){0.f, 0.f, 0.f, 0.f};
                const int cc = 32 * p + 8 * (m >> 2) + 4 * e + (m & 3);
#pragma unroll
                for (int ks = 0; ks < 4; ++ks) if (ks <= kmax) {
                    const bf16x8 Afr = *(const LAS bf16x8*)(vt + cc * LDV + 32 * ks + 8 * q);
                    ac[e] = __builtin_amdgcn_mfma_f32_16x16x32_bf16(Afr, Bw[ks], ac[e], 0, 0, 0);
                }
            }
            const size_t off = (size_t)(row0 + t) * D + g * 128 + 32 * p + 8 * q;
            const u32x4 uv = *(const u32x4*)(U + off);
            u32x4 o;
            o.x = cvt_pk_bf16(bf_lo(uv.x) * (ac[0][0] + bias), bf_hi(uv.x) * (ac[0][1] + bias));
            o.y = cvt_pk_bf16(bf_lo(uv.y) * (ac[0][2] + bias), bf_hi(uv.y) * (ac[0][3] + bias));
            o.z = cvt_pk_bf16(bf_lo(uv.z) * (ac[1][0] + bias), bf_hi(uv.z) * (ac[1][1] + bias));
            o.w = cvt_pk_bf16(bf_lo(uv.w) * (ac[1][2] + bias), bf_hi(uv.w) * (ac[1][3] + bias));
            *(u32x4*)(Y + off) = o;
        }
    }
    __syncthreads();
}


#define XB_TMO      128
#define XB_XCNT(j)  (256  + 64 * (j))
#define XB_XSUB(j)  (1280 + 64 * (j))
#define XB_XGEN(j)  (2304 + 64 * (j))
#define XB_TOP      3328
#define XB_TOPGEN   3392
#define XCD_BAR_WORDS 3456
#define XB_SPIN_CAP (1u << 18)
__device__ __forceinline__ unsigned xb_ld(unsigned* p)              { return __hip_atomic_load(p, __ATOMIC_RELAXED, __HIP_MEMORY_SCOPE_AGENT); }
__device__ __forceinline__ unsigned xb_add(unsigned* p, unsigned v) { return __hip_atomic_fetch_add(p, v, __ATOMIC_RELAXED, __HIP_MEMORY_SCOPE_AGENT); }
__device__ __forceinline__ unsigned xb_xcc_id() { return (unsigned)__builtin_amdgcn_s_getreg((3 << 11) | 20) & 0xFu; }
#define XB_SPIN(cond, bar) do { unsigned _sp = 0; while (cond) { __builtin_amdgcn_s_sleep(1); \
    if ((++_sp & 255u) == 0u) { if (xb_ld(&(bar)[XB_TMO])) break; if (_sp > XB_SPIN_CAP) { atomicAdd(&(bar)[XB_TMO], 1u); break; } } } } while (0)
struct XcdBarrier { unsigned* bar; unsigned x; volatile LAS unsigned* st; };
__device__ __forceinline__ XcdBarrier xcd_barrier_post(unsigned* bar, volatile LAS unsigned* st) {
    XcdBarrier b; b.bar = bar; b.x = xb_xcc_id(); b.st = st;
    if (threadIdx.x == 0) (void)xb_add(&bar[XB_XCNT(b.x)], 1u);
    return b;
}
__device__ __forceinline__ void xcd_barrier_complete(unsigned* bar, unsigned x, unsigned& nloc, unsigned& nx) {
    const unsigned G = gridDim.x * gridDim.y * gridDim.z;
    unsigned sum, cnt, mine, sp = 0u;
    for (;;) {
        sum = 0u; cnt = 0u; mine = 0u;
#pragma unroll
        for (unsigned j = 0; j < 16; ++j) { const unsigned c = xb_ld(&bar[XB_XCNT(j)]); sum += c; cnt += (c > 0u) ? 1u : 0u; mine = (j == x) ? c : mine; }
        if (sum == G) break;
        __builtin_amdgcn_s_sleep(1);
        if ((++sp & 255u) == 0u) { if (xb_ld(&bar[XB_TMO])) break; if (sp > XB_SPIN_CAP) { atomicAdd(&bar[XB_TMO], 1u); break; } }
    }
    nloc = mine > 0u ? mine : 1u; nx = cnt > 0u ? cnt : 1u;
}
__device__ __forceinline__ void xcd_barrier(const XcdBarrier& b) {
    asm volatile("s_waitcnt vmcnt(0)" ::: "memory");
    __syncthreads();
    if (threadIdx.x == 0) {
        unsigned* bar = b.bar;
        __builtin_amdgcn_s_waitcnt(0);
        unsigned nloc = b.st[0], nx = b.st[1];
        if (nloc == 0u) { xcd_barrier_complete(bar, b.x, nloc, nx); b.st[0] = nloc; b.st[1] = nx; }
        const unsigned old = xb_add(&bar[XB_XSUB(b.x)], 1u);
        const unsigned gen = old / nloc;
        if (old + 1u == (gen + 1u) * nloc) {
            __builtin_amdgcn_fence(__ATOMIC_RELEASE, "agent");
            asm volatile("s_waitcnt vmcnt(0)" ::: "memory");
            const unsigned og = xb_add(&bar[XB_TOP], 1u);
            const unsigned tg = og / nx;
            if (og + 1u == (tg + 1u) * nx) xb_add(&bar[XB_TOPGEN], 1u);
            else XB_SPIN(xb_ld(&bar[XB_TOPGEN]) == tg, bar);
            __builtin_amdgcn_fence(__ATOMIC_ACQUIRE, "agent");
            xb_add(&bar[XB_XGEN(b.x)], 1u);
            asm volatile("s_waitcnt vmcnt(0)" ::: "memory");
        } else {
            XB_SPIN(xb_ld(&bar[XB_XGEN(b.x)]) == gen, bar);
            __builtin_amdgcn_fence(__ATOMIC_ACQUIRE, "agent");
            asm volatile("s_waitcnt vmcnt(0)" ::: "memory");
        }
    }
    __syncthreads();
}

__global__ void __launch_bounds__(512, 2) trunk_fwd(Args args) {
    extern __shared__ __attribute__((aligned(16))) unsigned char lds_raw[];
    LAS unsigned char* lds = (LAS unsigned char*)lds_raw;
    const int G_ = gridDim.x, bx = blockIdx.x;
    const int NGW = G_ * 8, NGT = G_ * 512;
#define PHASE_IDS() int tid = threadIdx.x; asm volatile("" : "+v"(tid)); const int lane = tid & 63, wave = __builtin_amdgcn_readfirstlane(tid >> 6), gw = bx * 8 + wave, gtid = bx * 512 + tid; (void)lane; (void)wave; (void)gw; (void)gtid
    unsigned char* ws = args.ws;
    float* X = args.out;
    float* SSP = (float*)(ws + WS_SSP);
    bf16_t* XB = (bf16_t*)(ws + WS_XB);
    unsigned char* BIG = ws + WS_BIG;
    const int lo = args.lo, hi = args.hi;
    int ph = 0;
#define RUN() (ph >= lo && ph < hi)
    volatile LAS unsigned* bst = (volatile LAS unsigned*)(lds + 135168);
    if (threadIdx.x < 2) bst[threadIdx.x] = 0u;
    __syncthreads();
    if (hi < 0) cg::this_grid().sync();
    XcdBarrier xbar = xcd_barrier_post((unsigned*)(ws + WS_BAR), bst);
#define SEAM() do { ++ph; if (ph > lo && ph < hi) xcd_barrier(xbar); } while (0)

    _Pragma("unroll 1") for (int rep_ = 0; rep_ < (RUN() ? REP_0 : 0); ++rep_) { PHASE_IDS();
        LAS float* scr = (LAS float*)(lds + wave * 16384);
        {
            f32x4 R0[8], R1[8];
            int it = gw;
            if (it < P0_NITEMS) { const P0Item d = p0_decode(args, ws, it); p0_load(d, lane, R0); }
#pragma unroll 1
            for (; it < P0_NITEMS; it += 2 * NGW) {
                const int it1 = it + NGW, it2 = it + 2 * NGW;
                if (it1 < P0_NITEMS) { const P0Item d1 = p0_decode(args, ws, it1); p0_load(d1, lane, R1); }
                { const P0Item d = p0_decode(args, ws, it); p0_store(d, lane, R0, scr); }
                if (it2 < P0_NITEMS) { const P0Item d2 = p0_decode(args, ws, it2); p0_load(d2, lane, R0); }
                if (it1 < P0_NITEMS) { const P0Item d1 = p0_decode(args, ws, it1); p0_store(d1, lane, R1, scr); }
            }
        }
        for (int id = gtid; id < 2 * NH * 2 * HD * 12; id += NGT) {
            const int k8 = id % 12, n = (id / 12) % HD, qq = (id / (12 * HD)) & 1, jh = id / (12 * HD * 2);
            const float* Wg = (qq ? args.in[9] : args.in[7]) + (size_t)jh * HD * HD;
            float v[8];
#pragma unroll
            for (int j = 0; j < 8; ++j) { const int k = 8 * k8 + j; v[j] = (k < HD) ? Wg[k * HD + n] : 0.f; }
            u32x4 o; o.x = cvt_pk_bf16(v[0], v[1]); o.y = cvt_pk_bf16(v[2], v[3]); o.z = cvt_pk_bf16(v[4], v[5]); o.w = cvt_pk_bf16(v[6], v[7]);
            *(u32x4*)((bf16_t*)(ws + WS_GW) + (size_t)id * 8) = o;
        }
        for (int id = gtid; id < 8 * 128 * 16; id += NGT) {
            const int s8 = id & 15, t = (id >> 4) & 127;
            const float* p = args.in[15] + (size_t)id * 8; float v[8];
#pragma unroll
            for (int j = 0; j < 8; ++j) v[j] = (8 * s8 + j <= t) ? p[j] : 0.f;
            u32x4 o; o.x = cvt_pk_bf16(v[0], v[1]); o.y = cvt_pk_bf16(v[2], v[3]); o.z = cvt_pk_bf16(v[4], v[5]); o.w = cvt_pk_bf16(v[6], v[7]);
            *(u32x4*)((bf16_t*)(ws + WS_WSB) + (size_t)id * 8) = o;
        }
        const float* x = args.in[0];
        for (int r = gw; r < M; r += 2 * NGW) {
            const int r1 = r + NGW;
            f32x4 va[4], vb[4];
#pragma unroll
            for (int j = 0; j < 4; ++j) { va[j] = __builtin_nontemporal_load((const f32x4*)(x + (size_t)r * D) + lane + 64 * j); vb[j] = (r1 < M) ? __builtin_nontemporal_load((const f32x4*)(x + (size_t)r1 * D) + lane + 64 * j) : (f32x4){0.f, 0.f, 0.f, 0.f}; }
            float sa = 0.f, sb = 0.f;
            unsigned long long* oa = (unsigned long long*)(XB + (size_t)r * D) + lane; unsigned long long* ob = (unsigned long long*)(XB + (size_t)r1 * D) + lane;
#pragma unroll
            for (int j = 0; j < 4; ++j) {
                sa += (va[j][0] * va[j][0] + va[j][1] * va[j][1]) + (va[j][2] * va[j][2] + va[j][3] * va[j][3]);
                sb += (vb[j][0] * vb[j][0] + vb[j][1] * vb[j][1]) + (vb[j][2] * vb[j][2] + vb[j][3] * vb[j][3]);
                oa[64 * j] = (unsigned long long)cvt_pk_bf16(va[j][0], va[j][1]) | ((unsigned long long)cvt_pk_bf16(va[j][2], va[j][3]) << 32);
                if (r1 < M) ob[64 * j] = (unsigned long long)cvt_pk_bf16(vb[j][0], vb[j][1]) | ((unsigned long long)cvt_pk_bf16(vb[j][2], vb[j][3]) << 32);
            }
            sa = wave_sum(sa); sb = wave_sum(sb);
            if (lane < 16) { SSP[(size_t)r * 16 + lane] = (lane == 0) ? sa : 0.f; if (r1 < M) SSP[(size_t)r1 * 16 + lane] = (lane == 0) ? sb : 0.f; }
        }
    }
    SEAM();

#pragma unroll 1
    for (int L = 0; L < 4; ++L) {
        const int kind = L % 3, j = L / 3;
        const bf16_t* Ymix; const bf16_t* Wout; int Kout;
        if (kind == 0) {
            bf16_t* Gb = (bf16_t*)(BIG + A_G); bf16_t* XRb = (bf16_t*)(BIG + A_XR); bf16_t* Yb = (bf16_t*)(BIG + A_Y);
            float* AGG = (float*)(BIG + A_AGG);
            _Pragma("unroll 1") for (int rep_ = 0; rep_ < (RUN() ? REP_1 : 0); ++rep_) { PHASE_IDS();
                pg8::Gemm g{XB, (const bf16_t*)(ws + W_AWIN) + (size_t)j * D * 2 * DR, M, 2 * DR, D}; pg8::StaticOrder S; S.init(M, 2 * DR, G_, bx);
                pg8::EpiAct<0> E{Gb, DR, DR, (size_t)(A_XR - A_G) / 2, SSP, nullptr};
                pg8::gemm_phase<pg8::EpiAct<0>, pg8::StaticOrder>(lds, g, S, E);
            }
            SEAM();
            const float* cw = args.in[5] + (size_t)j * 4 * DR; const float* cb = args.in[6] + (size_t)j * DR;
            const bf16_t* GWl = (const bf16_t*)(ws + WS_GW) + (size_t)j * NH * 2 * HD * 96;
            const float* gab = args.in[8] + (size_t)j * DR; const float* gxb = args.in[10] + (size_t)j * DR; const float* lam = args.in[11] + (size_t)j * DR;
            _Pragma("unroll 1") for (int rep_ = 0; rep_ < (RUN() ? REP_2 : 0); ++rep_) { PHASE_IDS();
#pragma unroll 1
                for (int bu = bx; bu < 256; bu += G_) a_block<false>(lds, bu, tid, lane, wave, XRb, Gb, Yb, AGG, cw, cb, GWl, gab, gxb, lam);
            }
            SEAM();
            _Pragma("unroll 1") for (int rep_ = 0; rep_ < (RUN() ? REP_4 : 0); ++rep_) { PHASE_IDS();
#pragma unroll 1
                for (int bu = bx; bu < 256; bu += G_) a_block<true>(lds, bu, tid, lane, wave, XRb, Gb, Yb, AGG, cw, cb, GWl, gab, gxb, lam);
            }
            SEAM();
            Ymix = Yb; Wout = (const bf16_t*)(ws + W_AWOUT) + (size_t)j * DR * D; Kout = DR;
        } else if (kind == 1) {
            bf16_t* Ub = (bf16_t*)(BIG + B_U); bf16_t* Vb = (bf16_t*)(BIG + B_V); bf16_t* Yb = (bf16_t*)(BIG + B_Y); float* SSV = (float*)(BIG + B_SSV);
            _Pragma("unroll 1") for (int rep_ = 0; rep_ < (RUN() ? REP_5 : 0); ++rep_) { PHASE_IDS();
                pg8::Gemm g{XB, (const bf16_t*)(ws + W_BWIN), M, 2 * D, D}; pg8::StaticOrder S; S.init(M, 2 * D, G_, bx);
                pg8::EpiAct<2> E{Ub, D, D, (size_t)(B_V - B_U) / 2, SSP, SSV};
                pg8::gemm_phase<pg8::EpiAct<2>, pg8::StaticOrder>(lds, g, S, E);
            }
            SEAM();
            _Pragma("unroll 1") for (int rep_ = 0; rep_ < (RUN() ? REP_6 : 0); ++rep_) { PHASE_IDS();
#pragma unroll 1
                for (int u = bx; u < 128 * 8; u += G_) sgu_unit(lds, u, tid, lane, wave, Ub, Vb, Yb, SSV, args.in[14], (const bf16_t*)(ws + WS_WSB), args.in[16]);
            }
            SEAM();
            Ymix = Yb; Wout = (const bf16_t*)(ws + W_BWOUT); Kout = D;
        } else {
            bf16_t* GCX = (bf16_t*)(BIG + C_GCX); bf16_t* Yb = (bf16_t*)(BIG + C_Y);
            _Pragma("unroll 1") for (int rep_ = 0; rep_ < (RUN() ? REP_7 : 0); ++rep_) { PHASE_IDS();
                pg8::Gemm g{XB, (const bf16_t*)(ws + W_CWIN), M, 3 * D, D}; pg8::StaticOrder S; S.init(M, 3 * D, G_, bx);
                pg8::EpiAct<3> E{GCX, 3 * D, 0, 0, SSP, nullptr};
                pg8::gemm_phase<pg8::EpiAct<3>, pg8::StaticOrder>(lds, g, S, E);
            }
            SEAM();
            _Pragma("unroll 1") for (int rep_ = 0; rep_ < (RUN() ? REP_8 : 0); ++rep_) { PHASE_IDS();
                const float* cw = args.in[19];
                for (int id = gtid; id < (M / 16) * 128; id += NGT) {
                    const int cgp = id & 127, r = id >> 7, c0 = 8 * cgp, rowb = r * 16;
                    f32x4 w[3][2];
#pragma unroll
                    for (int k = 0; k < 3; ++k) { w[k][0] = *(const f32x4*)(cw + k * D + c0); w[k][1] = *(const f32x4*)(cw + k * D + c0 + 4); }
                    float p2[8], p1[8];
#pragma unroll
                    for (int jj = 0; jj < 8; ++jj) { p2[jj] = 0.f; p1[jj] = 0.f; }
                    if ((rowb & (SEQ - 1)) != 0) {
                        const u32x4 ga = *(const u32x4*)(GCX + (size_t)(rowb - 2) * 3 * D + D + c0), xa = *(const u32x4*)(GCX + (size_t)(rowb - 2) * 3 * D + 2 * D + c0);
                        const u32x4 gb_ = *(const u32x4*)(GCX + (size_t)(rowb - 1) * 3 * D + D + c0), xb_ = *(const u32x4*)(GCX + (size_t)(rowb - 1) * 3 * D + 2 * D + c0);
                        p2[0] = bf_lo(ga.x) * bf_lo(xa.x); p2[1] = bf_hi(ga.x) * bf_hi(xa.x); p2[2] = bf_lo(ga.y) * bf_lo(xa.y); p2[3] = bf_hi(ga.y) * bf_hi(xa.y);
                        p2[4] = bf_lo(ga.z) * bf_lo(xa.z); p2[5] = bf_hi(ga.z) * bf_hi(xa.z); p2[6] = bf_lo(ga.w) * bf_lo(xa.w); p2[7] = bf_hi(ga.w) * bf_hi(xa.w);
                        p1[0] = bf_lo(gb_.x) * bf_lo(xb_.x); p1[1] = bf_hi(gb_.x) * bf_hi(xb_.x); p1[2] = bf_lo(gb_.y) * bf_lo(xb_.y); p1[3] = bf_hi(gb_.y) * bf_hi(xb_.y);
                        p1[4] = bf_lo(gb_.z) * bf_lo(xb_.z); p1[5] = bf_hi(gb_.z) * bf_hi(xb_.z); p1[6] = bf_lo(gb_.w) * bf_lo(xb_.w); p1[7] = bf_hi(gb_.w) * bf_hi(xb_.w);
                    }
#pragma unroll 4
                    for (int t = 0; t < 16; ++t) {
                        const size_t ro = (size_t)(rowb + t) * 3 * D + c0;
                        const u32x4 bb = *(const u32x4*)(GCX + ro), gc = *(const u32x4*)(GCX + ro + D), xv = *(const u32x4*)(GCX + ro + 2 * D);
                        float p0[8], gbv[8];
                        p0[0] = bf_lo(gc.x) * bf_lo(xv.x); p0[1] = bf_hi(gc.x) * bf_hi(xv.x); p0[2] = bf_lo(gc.y) * bf_lo(xv.y); p0[3] = bf_hi(gc.y) * bf_hi(xv.y);
                        p0[4] = bf_lo(gc.z) * bf_lo(xv.z); p0[5] = bf_hi(gc.z) * bf_hi(xv.z); p0[6] = bf_lo(gc.w) * bf_lo(xv.w); p0[7] = bf_hi(gc.w) * bf_hi(xv.w);
                        gbv[0] = bf_lo(bb.x); gbv[1] = bf_hi(bb.x); gbv[2] = bf_lo(bb.y); gbv[3] = bf_hi(bb.y); gbv[4] = bf_lo(bb.z); gbv[5] = bf_hi(bb.z); gbv[6] = bf_lo(bb.w); gbv[7] = bf_hi(bb.w);
                        float y[8];
#pragma unroll
                        for (int jj = 0; jj < 8; ++jj) { y[jj] = gbv[jj] * (w[0][jj >> 2][jj & 3] * p2[jj] + w[1][jj >> 2][jj & 3] * p1[jj] + w[2][jj >> 2][jj & 3] * p0[jj]); p2[jj] = p1[jj]; p1[jj] = p0[jj]; }
                        u32x4 o; o.x = cvt_pk_bf16(y[0], y[1]); o.y = cvt_pk_bf16(y[2], y[3]); o.z = cvt_pk_bf16(y[4], y[5]); o.w = cvt_pk_bf16(y[6], y[7]);
                        *(u32x4*)(Yb + (size_t)(rowb + t) * D + c0) = o;
                    }
                }
            }
            SEAM();
            Ymix = Yb; Wout = (const bf16_t*)(ws + W_CWOUT); Kout = D;
        }
        _Pragma("unroll 1") for (int rep_ = 0; rep_ < (RUN() ? REP_9 : 0); ++rep_) { PHASE_IDS();
            pg8::Gemm g{Ymix, Wout, M, D, Kout}; pg8::StaticOrder S; S.init(M, D, G_, bx);
            pg8::EpiRes E{XB, SSP};
            pg8::gemm_phase<pg8::EpiRes, pg8::StaticOrder>(lds, g, S, E);
        }
        SEAM();
        _Pragma("unroll 1") for (int rep_ = 0; rep_ < (RUN() ? REP_10 : 0); ++rep_) { PHASE_IDS();
            pg8::Gemm g{XB, (const bf16_t*)(ws + W_W1) + (size_t)L * D * FF, M, FF, D}; pg8::StaticOrder S; S.init(M, FF, G_, bx);
            pg8::EpiAct<1> E{(bf16_t*)BIG, FF, 0, 0, SSP, nullptr};
            pg8::gemm_phase<pg8::EpiAct<1>, pg8::StaticOrder>(lds, g, S, E);
        }
        SEAM();
        _Pragma("unroll 1") for (int rep_ = 0; rep_ < (RUN() ? REP_11 : 0); ++rep_) { PHASE_IDS();
            pg8::Gemm g{(const bf16_t*)BIG, (const bf16_t*)(ws + W_W2) + (size_t)L * FF * D, M, D, FF}; pg8::StaticOrder S; S.init(M, D, G_, bx);
            pg8::EpiRes E{XB, SSP};
            pg8::gemm_phase<pg8::EpiRes, pg8::StaticOrder>(lds, g, S, E);
        }
        SEAM();
    }
    _Pragma("unroll 1") for (int rep_ = 0; rep_ < (RUN() ? REP_12 : 0); ++rep_) { PHASE_IDS();
        const float* fg = args.in[3];
        for (int r = gw; r < M; r += NGW) {
            float s = (lane < 16) ? SSP[(size_t)r * 16 + lane] : 0.f;
            s = wave_sum(s);
            const float rs = __builtin_amdgcn_rsqf(s * (1.0f / 1024.0f) + EPS);
            const u32x4* xr = (const u32x4*)(XB + (size_t)r * D) + lane; const f32x4* gr = (const f32x4*)fg + 2 * lane; f32x4* orow = (f32x4*)(X + (size_t)r * D) + 2 * lane;
#pragma unroll
            for (int jj = 0; jj < 2; ++jj) { const u32x4 v = xr[64 * jj]; const f32x4 g0 = gr[128 * jj], g1 = gr[128 * jj + 1];
                f32x4 o0, o1; o0[0] = bf_lo(v.x) * rs * g0[0]; o0[1] = bf_hi(v.x) * rs * g0[1]; o0[2] = bf_lo(v.y) * rs * g0[2]; o0[3] = bf_hi(v.y) * rs * g0[3];
                o1[0] = bf_lo(v.z) * rs * g1[0]; o1[1] = bf_hi(v.z) * rs * g1[1]; o1[2] = bf_lo(v.w) * rs * g1[2]; o1[3] = bf_hi(v.w) * rs * g1[3];
                __builtin_nontemporal_store(o0, orow + 128 * jj); __builtin_nontemporal_store(o1, orow + 128 * jj + 1); }
        }
    }
#undef RUN
#undef SEAM
}

extern "C" void kernel_launch(void* const* d_in, const int* in_sizes, int n_in, void* d_out, int out_size, void* d_ws, size_t ws_size, hipStream_t stream) {
    static int grid = 0;
    if (grid == 0) {
        if (n_in != 23 || in_sizes[0] != M * D || out_size != M * D || ws_size < WS_END) {
            fprintf(stderr, "kernel_launch: unexpected shapes (n_in %d, in0 %d, out %d, ws %zu < %zu); nothing launched\n", n_in, n_in > 0 ? in_sizes[0] : -1, out_size, ws_size, (size_t)WS_END); grid = -1; return; }
        int dev = 0, cus = 0, per_cu = 0;
        if (hipGetDevice(&dev) != hipSuccess || hipDeviceGetAttribute(&cus, hipDeviceAttributeMultiprocessorCount, dev) != hipSuccess) { grid = -1; return; }
        if (hipFuncSetAttribute((const void*)trunk_fwd, hipFuncAttributeMaxDynamicSharedMemorySize, LDS_BYTES) != hipSuccess) { fprintf(stderr, "kernel_launch: hipFuncSetAttribute failed\n"); grid = -1; return; }
        if (hipOccupancyMaxActiveBlocksPerMultiprocessor(&per_cu, (const void*)trunk_fwd, 512, LDS_BYTES) != hipSuccess || per_cu < 1) { fprintf(stderr, "kernel_launch: occupancy query gave %d\n", per_cu); per_cu = 1; }
        (void)hipGetLastError();
        grid = cus * per_cu;
    }
    if (grid < 0) return;
    if (hipMemsetAsync((char*)d_ws + WS_BAR, 0, XCD_BAR_WORDS * 4, stream) != hipSuccess) { fprintf(stderr, "kernel_launch: hipMemsetAsync failed\n"); return; }
    Args a{};
    for (int i = 0; i < 23; ++i) a.in[i] = (const float*)d_in[i];
    a.out = (float*)d_out; a.ws = (unsigned char*)d_ws;
#if MK_MULTI
    for (int p = 0; p < NPHASE; ++p) { a.lo = p; a.hi = p + 1; hipLaunchKernelGGL(trunk_fwd, dim3(grid), dim3(512), LDS_BYTES, stream, a); }
#else
    a.lo = 0; a.hi = NPHASE;
    void* kargs[] = {(void*)&a};
    hipError_t e = hipLaunchCooperativeKernel((const void*)trunk_fwd, dim3(grid), dim3(512), kargs, LDS_BYTES, stream);
    if (e != hipSuccess) fprintf(stderr, "kernel_launch: cooperative launch failed: %s (grid %d)\n", hipGetErrorString(e), grid);
#endif
}
```
